# Optimizing an MI355X kernel written in HIP

```python
import jax
import jax.numpy as jnp
from jax import lax
import numpy as np

D_MODEL = 4096
BATCH = 2
SEQ = 8192
DEPTH = 1

CHUNK = 64
MIX_WIDTH = D_MODEL
GMLP_WIDTH = MIX_WIDTH // 2
GMLP_HEADS = 16
GMLP_HEAD_CH = GMLP_WIDTH // GMLP_HEADS
GMLP_BLOCK = 128
RWKV_WIDTH = MIX_WIDTH - GMLP_WIDTH
RWKV_HEAD_DIM = 64
RWKV_HEADS = RWKV_WIDTH // RWKV_HEAD_DIM
DECAY_LORA = 64
ICLR_LORA = 64
GATE_LORA = 256
SHIFT_WIDTH = 3 * RWKV_WIDTH + DECAY_LORA + ICLR_LORA + GATE_LORA
PROJ_WIDTH = 2 * GMLP_WIDTH + SHIFT_WIDTH
D_FF = 4 * D_MODEL
RMS_EPS = 1e-6
LN_EPS = 1e-5
GN_EPS = RWKV_HEAD_DIM * 1e-5
L2_EPS = 1e-12

kernel_name = 'hybrid_gmlp_rwkv7_sandwich_block'


def rms_norm(x, g):
    xf = x.astype(jnp.float32)
    y = xf * lax.rsqrt(jnp.mean(xf * xf, axis=-1, keepdims=True) + RMS_EPS)
    return (y * g.astype(jnp.float32)).astype(x.dtype)


def layer_norm(x, g, b):
    xf = x.astype(jnp.float32)
    xc = xf - jnp.mean(xf, axis=-1, keepdims=True)
    y = xc * lax.rsqrt(jnp.mean(xc * xc, axis=-1, keepdims=True) + LN_EPS)
    return (y * g.astype(jnp.float32) + b.astype(jnp.float32)).astype(x.dtype)


def block_causal_mask():
    pos = jnp.arange(GMLP_BLOCK)
    return (pos[None, :] // CHUNK) <= (pos[:, None] // CHUNK)


def gmlp_spatial_gating(p_g, ln_g, ln_b, ws, bs):
    B, T, _ = p_g.shape
    z = jax.nn.gelu(p_g)
    u, v = z[..., :GMLP_WIDTH], z[..., GMLP_WIDTH:]
    v = layer_norm(v, ln_g, ln_b)
    vb = v.reshape(B, T // GMLP_BLOCK, GMLP_BLOCK, GMLP_HEADS, GMLP_HEAD_CH)
    ws_m = jnp.where(block_causal_mask()[None], ws, jnp.zeros((), ws.dtype))
    mixed = jnp.einsum('hij,bnjhc->bnihc', ws_m, vb) + bs.T[:, :, None]
    return u * mixed.reshape(B, T, GMLP_WIDTH)


def rwkv7_scan(r, w, k, v, kk, a):
    B, T, H, N = r.shape

    def step(S, inp):
        r_t, w_t, k_t, v_t, kk_t, a_t = inp
        sa = jnp.einsum('bhvk,bhk->bhv', S, -kk_t)
        S = (S * w_t[:, :, None, :]
             + sa[..., None] * (kk_t * a_t)[:, :, None, :]
             + v_t[..., None] * k_t[:, :, None, :])
        return S, jnp.einsum('bhvk,bhk->bhv', S, r_t)

    xs = tuple(jnp.moveaxis(t.astype(jnp.float32), 1, 0) for t in (r, w, k, v, kk, a))
    S0 = jnp.zeros((B, H, N, N), jnp.float32)
    _, y = lax.scan(step, S0, xs)
    return jnp.moveaxis(y, 0, 1)


def rwkv7_time_mix(p_s, mu, w0, w_up, a0, a_up, g_up, k_k, k_a, r_k, lnx_g, lnx_b):
    B, T, _ = p_s.shape
    H, N = RWKV_HEADS, RWKV_HEAD_DIM
    p_prev = jnp.pad(p_s[:, :-1], ((0, 0), (1, 0), (0, 0)))
    p_s = p_s + (p_prev - p_s) * mu
    cuts = [RWKV_WIDTH, 2 * RWKV_WIDTH, 3 * RWKV_WIDTH,
            3 * RWKV_WIDTH + DECAY_LORA, 3 * RWKV_WIDTH + DECAY_LORA + ICLR_LORA]
    r, k, v, xw, xa, xg = jnp.split(p_s, cuts, axis=-1)
    w_log = -jax.nn.softplus(-(w0 + jnp.tanh(xw) @ w_up)) - 0.5
    decay = jnp.exp(-jnp.exp(w_log.astype(jnp.float32)))
    a = jax.nn.sigmoid(a0 + xa @ a_up)
    g = jax.nn.sigmoid(xg) @ g_up
    r, k, v, decay, a = (t.reshape(B, T, H, N) for t in (r, k, v, decay, a))
    kk = k.astype(jnp.float32) * k_k.reshape(H, N).astype(jnp.float32)
    kk = kk / jnp.maximum(jnp.sqrt(jnp.sum(kk * kk, axis=-1, keepdims=True)), L2_EPS)
    k = k * (1 + (a - 1) * k_a.reshape(H, N))
    y = rwkv7_scan(r, decay, k, v, kk, a)
    yc = y - jnp.mean(y, axis=-1, keepdims=True)
    y = yc * lax.rsqrt(jnp.mean(yc * yc, axis=-1, keepdims=True) + GN_EPS)
    y = y * lnx_g.reshape(H, N).astype(jnp.float32) + lnx_b.reshape(H, N).astype(jnp.float32)
    bonus = jnp.sum((r * k * r_k).astype(jnp.float32), axis=-1, keepdims=True)
    y = y + bonus * v.astype(jnp.float32)
    return (y.reshape(B, T, RWKV_WIDTH) * g.astype(jnp.float32)).astype(p_s.dtype)


def setup_inputs(seed: int = 0) -> dict:
    key = jax.random.key(seed)
    ks = jax.random.split(key, 24)
    f32 = jnp.float32
    L = DEPTH

    def nrm(k, shape, s):
        return s * jax.random.normal(k, shape, f32)

    return {
        'x': jax.random.normal(ks[0], (BATCH, SEQ, D_MODEL), f32),
        'pre_mix_g': 1.0 + nrm(ks[1], (L, D_MODEL), 0.05),
        'w_in': nrm(ks[2], (L, D_MODEL, PROJ_WIDTH), D_MODEL ** -0.5),
        'tshift_mu': jax.random.uniform(ks[3], (L, SHIFT_WIDTH), f32),
        'gmlp_ln_g': 1.0 + nrm(ks[4], (L, GMLP_WIDTH), 0.05),
        'gmlp_ln_b': nrm(ks[5], (L, GMLP_WIDTH), 0.02),
        'gmlp_ws': nrm(ks[6], (L, GMLP_HEADS, GMLP_BLOCK, GMLP_BLOCK), GMLP_BLOCK ** -0.5),
        'gmlp_bs': 1.0 + nrm(ks[7], (L, GMLP_HEADS, GMLP_BLOCK), 0.1),
        'decay_w0': 0.5 + nrm(ks[8], (L, RWKV_WIDTH), 1.0),
        'decay_up': nrm(ks[9], (L, DECAY_LORA, RWKV_WIDTH), 0.5 * DECAY_LORA ** -0.5),
        'iclr_a0': nrm(ks[10], (L, RWKV_WIDTH), 0.5),
        'iclr_up': nrm(ks[11], (L, ICLR_LORA, RWKV_WIDTH), ICLR_LORA ** -0.5),
        'gate_up': nrm(ks[12], (L, GATE_LORA, RWKV_WIDTH), GATE_LORA ** -0.5),
        'k_k': 0.85 + nrm(ks[13], (L, RWKV_WIDTH), 0.05),
        'k_a': 1.0 + nrm(ks[14], (L, RWKV_WIDTH), 0.05),
        'r_k': nrm(ks[15], (L, RWKV_HEADS, RWKV_HEAD_DIM), 0.1),
        'lnx_g': 1.0 + nrm(ks[16], (L, RWKV_WIDTH), 0.05),
        'lnx_b': nrm(ks[17], (L, RWKV_WIDTH), 0.02),
        'w_out': nrm(ks[18], (L, MIX_WIDTH, D_MODEL), MIX_WIDTH ** -0.5),
        'post_mix_g': 1.0 + nrm(ks[19], (L, D_MODEL), 0.05),
        'pre_ffn_g': 1.0 + nrm(ks[20], (L, D_MODEL), 0.05),
        'w_ff1': nrm(ks[21], (L, D_MODEL, D_FF), D_MODEL ** -0.5),
        'w_ff2': nrm(ks[22], (L, D_FF, D_MODEL), D_FF ** -0.5),
        'post_ffn_g': 1.0 + nrm(ks[23], (L, D_MODEL), 0.05),
    }


def reference(x, pre_mix_g, w_in, tshift_mu, gmlp_ln_g, gmlp_ln_b, gmlp_ws, gmlp_bs,
              decay_w0, decay_up, iclr_a0, iclr_up, gate_up, k_k, k_a, r_k, lnx_g, lnx_b,
              w_out, post_mix_g, pre_ffn_g, w_ff1, w_ff2, post_ffn_g):
    for l in range(DEPTH):
        h = rms_norm(x, pre_mix_g[l])
        p = h @ w_in[l]
        y_a = gmlp_spatial_gating(p[..., :2 * GMLP_WIDTH], gmlp_ln_g[l], gmlp_ln_b[l],
                                  gmlp_ws[l], gmlp_bs[l])
        y_b = rwkv7_time_mix(p[..., 2 * GMLP_WIDTH:], tshift_mu[l], decay_w0[l], decay_up[l],
                             iclr_a0[l], iclr_up[l], gate_up[l], k_k[l], k_a[l], r_k[l],
                             lnx_g[l], lnx_b[l])
        mix = jnp.concatenate([y_a, y_b], axis=-1) @ w_out[l]
        x = x + rms_norm(mix, post_mix_g[l])
        h = rms_norm(x, pre_ffn_g[l])
        f = jnp.square(jax.nn.relu(h @ w_ff1[l])) @ w_ff2[l]
        x = x + rms_norm(f, post_ffn_g[l])
    return x
```

```cpp
#include <hip/hip_runtime.h>
#include <hip/hip_cooperative_groups.h>
#include <cstdio>
namespace cg = cooperative_groups;
namespace pg8 {
#define PG8_LAS __attribute__((address_space(3)))
typedef unsigned short bf16_t;
typedef short bf16x8 __attribute__((ext_vector_type(8)));
typedef float f32x4 __attribute__((ext_vector_type(4)));
typedef unsigned u32x4 __attribute__((ext_vector_type(4)));
constexpr int BM = 256, BK = 64, HALF = 128, HTB = HALF * BK * 2  , STAGE_BYTES = 8 * HTB, NXCD = 8, WGM = 8;

__host__ __device__ __forceinline__ int lds_byte(int r, int c) { const int st = (r >> 4) * 2 + (c >> 5), rr = r & 15, cc = c & 31, ob = rr * 64 + cc * 2; return st * 1024 + (ob ^ (((ob >> 9) & 1) << 5)); }
__host__ __device__ __forceinline__ void stage_rc(int b, int& R, int& C) { const int st = b / 1024, sb = b % 1024, swz = sb ^ (((sb >> 9) & 1) << 5); R = (st >> 1) * 16 + swz / 64; C = (st & 1) * 32 + (swz % 64) / 2; }
__host__ __device__ __forceinline__ int perm32(int rho) { const int n = rho >> 4, i = rho & 15; return 8 * (i >> 2) + 4 * n + (i & 3); }

struct Unit { int pm, pn; };
struct Gemm { const bf16_t* A; const bf16_t* Bt; int M, N, K; };

struct StaticOrder {
    int nM, nN, nwg, G, c;
    __host__ __device__ void init(int M, int N, int G_, int c_) { nM = M / BM; nN = N / BM; nwg = nM * nN; G = G_; c = c_; }
    __host__ __device__ bool next(int i, Unit& u) const {
        const long L = (long)i * G + c; if (L >= nwg) return false;
        int wgid = (int)L; { const int q = nwg / NXCD, r = nwg % NXCD, xcd = wgid % NXCD, off = wgid / NXCD; wgid = (xcd < r ? xcd * (q + 1) : r * (q + 1) + (xcd - r) * q) + off; }
        const int nig = WGM * nN, gid = wgid / nig, fm = gid * WGM, gsz = (nM - fm) < WGM ? (nM - fm) : WGM;
        u.pm = fm + ((wgid % nig) % gsz); u.pn = (wgid % nig) / gsz; return true;
    }
    __device__ __forceinline__ void a_ready(const Unit&) const {}
    __device__ __forceinline__ void done(const Unit&) const {}
};
__device__ __forceinline__ unsigned cvt_pk_bf16(float lo, float hi) { unsigned r; asm volatile("v_cvt_pk_bf16_f32 %0, %1, %2" : "=v"(r) : "v"(lo), "v"(hi)); return r; }
typedef float f32x2 __attribute__((ext_vector_type(2)));
template <class Epi, class Sched, bool STAMP = false>
__device__ __forceinline__ void gemm_phase(PG8_LAS unsigned char* lds, const Gemm g, const Sched& S, const Epi& E, unsigned long long* stamps) {
    const int tid = threadIdx.x, wid = __builtin_amdgcn_readfirstlane(tid >> 6), lane = tid & 63, wr = wid >> 2, wc = wid & 3, fr = lane & 15, fq = lane >> 4;
    const int K = g.K, nt = K / BK;
    int ts_lo = 0, ts_hi = 0, nts = 0; const unsigned long long rt_entry = STAMP ? (unsigned long long)wall_clock64() : 0ull;
#define PG8_STAMP() do { if (STAMP && wid == 0 && nts < 64) { const unsigned long long _c = (unsigned long long)clock64(); \
        ts_lo = (lane == nts) ? (int)(unsigned)_c : ts_lo; ts_hi = (lane == nts) ? (int)(unsigned)(_c >> 32) : ts_hi; ++nts; } } while (0)
    PG8_STAMP();
    unsigned voffA[2], voffB[2];
#pragma unroll
    for (int i = 0; i < 2; ++i) { int R, C; stage_rc(tid * 16 + i * 8192, R, C); const int Rb = Epi::PERM ? ((R & ~31) + perm32(R & 31)) : R;
        voffA[i] = (unsigned)(R * K + C) * 2u; voffB[i] = (unsigned)(Rb * K + C) * 2u; }
    const size_t kstep = (size_t)(BK * 2);
    const size_t hstep = (size_t)HALF * K * 2;
    const size_t tstep = 2 * hstep;
    const unsigned ldsw = (unsigned)wid * 1024u;
    const int aoff = lds_byte(wr * 64 + fr, fq * 8), boff = lds_byte(wc * 32 + fr, fq * 8);
#define PG8_SA(b, h) (((b) * 2 + (h)) * HTB)
#define PG8_SB(b, h) ((4 + (b) * 2 + (h)) * HTB)
#define PG8_STAGE(bufoff, gbase, voff) do { _Pragma("unroll") for (int _i = 0; _i < 2; ++_i) \
        __builtin_amdgcn_global_load_lds((const unsigned*)((const char*)(gbase) + (voff)[_i]), (PG8_LAS unsigned*)(lds + (bufoff) + ldsw + _i * 8192), 16, 0, 0); } while (0)
#define PG8_LDA(dst, b, h) do { _Pragma("unroll") for (int m = 0; m < 4; ++m) _Pragma("unroll") for (int k = 0; k < 2; ++k) dst[m][k] = *(const PG8_LAS bf16x8*)(lds + PG8_SA(b, h) + aoff + m * 2048 + k * 1024); } while (0)
#define PG8_LDB(dst, b, h) do { _Pragma("unroll") for (int n = 0; n < 2; ++n) _Pragma("unroll") for (int k = 0; k < 2; ++k) dst[n][k] = *(const PG8_LAS bf16x8*)(lds + PG8_SB(b, h) + boff + n * 2048 + k * 1024); } while (0)
#define PG8_MMA(ai, bj, At, Bt) do { __builtin_amdgcn_s_setprio(1); _Pragma("unroll") for (int m = 0; m < 4; ++m) _Pragma("unroll") for (int n = 0; n < 2; ++n) _Pragma("unroll") for (int k = 0; k < 2; ++k) \
        acc[ai][bj][m][n] = __builtin_amdgcn_mfma_f32_16x16x32_bf16(Bt[n][k], At[m][k], acc[ai][bj][m][n], 0, 0, 0); __builtin_amdgcn_s_setprio(0); } while (0)
#define PG8_WAIT_V(n) asm volatile("s_waitcnt vmcnt(" #n ")" ::: "memory")
#define PG8_WAIT_L(n) asm volatile("s_waitcnt lgkmcnt(" #n ")" ::: "memory")
#define PG8_BAR __builtin_amdgcn_s_barrier()
#define PG8_SCHED __builtin_amdgcn_sched_barrier(0)
    Unit cur, nxt; int ui = 0;
    if (!S.next(0, cur)) return;
    f32x4 acc[2][2][4][2];
#pragma unroll
    for (int a = 0; a < 2; ++a)
#pragma unroll
        for (int b = 0; b < 2; ++b)
#pragma unroll
            for (int m = 0; m < 4; ++m)
#pragma unroll
                for (int n = 0; n < 2; ++n) acc[a][b][m][n] = (f32x4){0.f, 0.f, 0.f, 0.f};
    bf16x8 At[4][2], B0[2][2], B1[2][2];
    const char* cA = (const char*)g.A + (size_t)cur.pm * tstep; const char* cB = (const char*)g.Bt + (size_t)cur.pn * tstep;
    S.a_ready(cur);
    PG8_STAGE(PG8_SB(0, 0), cB, voffB); PG8_STAGE(PG8_SA(0, 0), cA, voffA); PG8_STAGE(PG8_SB(0, 1), cB + hstep, voffB); PG8_STAGE(PG8_SA(0, 1), cA + hstep, voffA);
    if (wr == 1) PG8_BAR;
    PG8_WAIT_V(4); PG8_BAR;
    PG8_STAGE(PG8_SB(1, 0), cB + kstep, voffB); PG8_STAGE(PG8_SA(1, 0), cA + kstep, voffA); PG8_STAGE(PG8_SB(1, 1), cB + hstep + kstep, voffB);
    PG8_WAIT_V(6); PG8_BAR;
    PG8_STAMP();
    for (;;) {
        const bool has_next = S.next(ui + 1, nxt);
        const char* nA = has_next ? (const char*)g.A + (size_t)nxt.pm * tstep : cA; const char* nB = has_next ? (const char*)g.Bt + (size_t)nxt.pn * tstep : cB;
#pragma unroll 1
        for (int t = 0; t < nt; t += 2) {
            const bool last = (t == nt - 2);
            const char* a1 = cA + (size_t)(t + 1) * kstep;
            const char* a2 = last ? nA : cA + (size_t)(t + 2) * kstep; const char* b2 = last ? nB : cB + (size_t)(t + 2) * kstep;
            const char* a3 = a2 + kstep; const char* b3 = b2 + kstep;
            if (last && has_next) S.a_ready(nxt);
            PG8_LDB(B0, 0, 0); PG8_SCHED; PG8_LDA(At, 0, 0); PG8_STAGE(PG8_SA(1, 1), a1 + hstep, voffA);
            PG8_WAIT_L(8); PG8_BAR; PG8_WAIT_L(0); PG8_MMA(0, 0, At, B0); PG8_BAR; PG8_SCHED;
            PG8_LDB(B1, 0, 1); PG8_STAGE(PG8_SB(0, 0), b2, voffB);
            PG8_BAR; PG8_WAIT_L(0); PG8_MMA(0, 1, At, B1); PG8_BAR;
            PG8_LDA(At, 0, 1); PG8_STAGE(PG8_SA(0, 0), a2, voffA);
            PG8_BAR; PG8_WAIT_L(0); PG8_MMA(1, 0, At, B0); PG8_BAR; PG8_SCHED;
            PG8_STAGE(PG8_SB(0, 1), b2 + hstep, voffB);
            PG8_WAIT_V(6); PG8_BAR; PG8_MMA(1, 1, At, B1); PG8_BAR;
            PG8_LDB(B0, 1, 0); PG8_SCHED; PG8_LDA(At, 1, 0); PG8_STAGE(PG8_SA(0, 1), a2 + hstep, voffA);
            PG8_WAIT_L(8); PG8_BAR; PG8_WAIT_L(0); PG8_MMA(0, 0, At, B0); PG8_BAR; PG8_SCHED;
            PG8_LDB(B1, 1, 1); PG8_STAGE(PG8_SB(1, 0), b3, voffB);
            PG8_BAR; PG8_WAIT_L(0); PG8_MMA(0, 1, At, B1); PG8_BAR;
            PG8_LDA(At, 1, 1); PG8_STAGE(PG8_SA(1, 0), a3, voffA);
            PG8_BAR; PG8_WAIT_L(0); PG8_MMA(1, 0, At, B0); PG8_BAR; PG8_SCHED;
            PG8_STAGE(PG8_SB(1, 1), b3 + hstep, voffB);
            PG8_WAIT_V(6); PG8_BAR; PG8_MMA(1, 1, At, B1); PG8_BAR;
        }
        PG8_STAMP();
        if constexpr (!Epi::AFTER_DRAIN) { E(acc, cur, wr, wc, fr, fq); S.done(cur); }
        PG8_STAMP();
        if (!has_next) break;
#pragma unroll
        for (int a = 0; a < 2; ++a)
#pragma unroll
            for (int b = 0; b < 2; ++b)
#pragma unroll
                for (int m = 0; m < 4; ++m)
#pragma unroll
                    for (int n = 0; n < 2; ++n) acc[a][b][m][n] = (f32x4){0.f, 0.f, 0.f, 0.f};
        cur = nxt; cA = nA; cB = nB; ++ui;
    }
    PG8_WAIT_V(0);
    if (wr == 0) PG8_BAR;
    PG8_BAR;
    if constexpr (Epi::AFTER_DRAIN) { E.fused(acc, cur, wr, wc, fr, fq, lds, wid, lane); S.done(cur); }
    PG8_STAMP();
    if (STAMP && wid == 0) { stamps[lane] = lane < nts ? (((unsigned long long)(unsigned)ts_hi << 32) | (unsigned)ts_lo) : 0ull;
        if (lane == 62) stamps[62] = rt_entry; if (lane == 63) stamps[63] = (unsigned long long)wall_clock64(); }
#undef PG8_STAMP
#undef PG8_SA
#undef PG8_SB
#undef PG8_STAGE
#undef PG8_LDA
#undef PG8_LDB
#undef PG8_MMA
#undef PG8_WAIT_V
#undef PG8_WAIT_L
#undef PG8_BAR
#undef PG8_SCHED
}
}

#define LAS __attribute__((address_space(3)))
typedef unsigned short bf16_t;
typedef short bf16x8 __attribute__((ext_vector_type(8)));
typedef float f32x4 __attribute__((ext_vector_type(4)));
typedef unsigned u32x4 __attribute__((ext_vector_type(4)));
typedef unsigned u32x2 __attribute__((ext_vector_type(2)));

constexpr int M_TOK = 16384, T_SEQ = 8192, DM = 4096, NPROJ = 10624, NPAD = 10752, FFD = 16384;
constexpr int GW = 2048, RW = 2048, PSW = 6528, LK = 384, LN_ = 6144;
constexpr int LDS_BYTES = 131072, NTHREADS = 512, NWAVES = 8;

constexpr size_t OFF_W1T = 0;
constexpr size_t OFF_W2T = OFF_W1T + (size_t)FFD * DM * 2;
constexpr size_t OFF_WOT = OFF_W2T + (size_t)FFD * DM * 2;
constexpr size_t OFF_BT2 = OFF_WOT + (size_t)DM * DM * 2;
constexpr size_t OFF_H   = OFF_BT2 + (size_t)LN_ * LK * 2;
constexpr size_t OFF_WIN = OFF_H + (size_t)M_TOK * DM * 2;
constexpr size_t OFF_Z   = OFF_WIN + (size_t)NPAD * DM * 2;
constexpr size_t OFF_PS  = OFF_Z + (size_t)M_TOK * DM * 2;
constexpr size_t OFF_Y   = OFF_PS + (size_t)M_TOK * PSW * 2;
constexpr size_t OFF_A2  = OFF_Y + (size_t)M_TOK * DM * 2;
constexpr size_t OFF_ST  = OFF_A2 + (size_t)M_TOK * LK * 2;
constexpr size_t OFF_SS1 = OFF_ST + (size_t)M_TOK * 8;
constexpr size_t OFF_SS2 = OFF_SS1 + (size_t)M_TOK * 64 * 4;
constexpr size_t WS_END  = OFF_SS2 + (size_t)M_TOK * 64 * 4;
constexpr size_t OFF_LO  = OFF_H;
constexpr size_t OFF_YRAW = OFF_Z;
constexpr size_t OFF_MIX = OFF_PS;
constexpr size_t OFF_HID = OFF_WIN;
constexpr size_t OFF_F   = OFF_H;
static_assert(OFF_HID + (size_t)M_TOK * FFD * 2 <= OFF_A2, "hid overflows");
static_assert(OFF_LO + (size_t)M_TOK * LN_ * 2 <= OFF_Z, "LO fits H + WinT");
static_assert(WS_END <= (size_t)1073741824, "workspace");

struct Params {
    const float* x; const float* pre_mix_g; const float* w_in; const float* mu; const float* ln_g; const float* ln_b;
    const float* ws; const float* bs; const float* w0; const float* w_up; const float* a0; const float* a_up; const float* g_up;
    const float* k_k; const float* k_a; const float* r_k; const float* lnx_g; const float* lnx_b; const float* w_out;
    const float* post_mix_g; const float* pre_ffn_g; const float* w_ff1; const float* w_ff2; const float* post_ffn_g;
    float* out; unsigned char* wsb; int ph_lo, ph_hi, coop, pad;
};

__device__ __forceinline__ unsigned pk2(float lo, float hi) { unsigned r; asm volatile("v_cvt_pk_bf16_f32 %0, %1, %2" : "=v"(r) : "v"(lo), "v"(hi)); return r; }
__device__ __forceinline__ float bflo(unsigned u) { return __uint_as_float(u << 16); }
__device__ __forceinline__ float bfhi(unsigned u) { return __uint_as_float(u & 0xffff0000u); }
__device__ __forceinline__ float bf1(bf16_t b) { return __uint_as_float(((unsigned)b) << 16); }
__device__ __forceinline__ bf16_t f2bf(float f) { return (bf16_t)(pk2(f, 0.f) & 0xffffu); }
__device__ __forceinline__ float wave_sum(float v) {
#pragma unroll
    for (int o = 1; o < 64; o <<= 1) v += __shfl_xor(v, o);
    return v;
}
template <int CTRL> __device__ __forceinline__ float dpp_mov(float x) { return __builtin_bit_cast(float, __builtin_amdgcn_update_dpp(0, __builtin_bit_cast(int, x), CTRL, 0xf, 0xf, true)); }
__device__ __forceinline__ float red16(float v) {
    v += dpp_mov<0xB1>(v);
    v += dpp_mov<0x4E>(v);
    v += dpp_mov<0x141>(v);
    v += dpp_mov<0x140>(v);
    return v;
}
#define LDS_WAIT() asm volatile("s_waitcnt lgkmcnt(0)" ::: "memory")

__device__ __forceinline__ float gelu_tanh(float x) {
    const float u = 0.7978845608028654f * (x + 0.044715f * x * x * x);
    const float e = __builtin_amdgcn_exp2f(-2.0f * 1.4426950408889634f * u);
    return x * __builtin_amdgcn_rcpf(1.0f + e);
}
struct EpiProj {
    static constexpr bool PERM = true, AFTER_DRAIN = false;
    bf16_t* Z; bf16_t* PS;
    __device__ __forceinline__ void operator()(const f32x4 (&acc)[2][2][4][2], const pg8::Unit& u, int wr, int wc, int fr, int fq) const {
        const int row0 = u.pm * 256 + wr * 64 + fr, colt = u.pn * 256 + wc * 32 + 8 * fq;
        const bool isz = u.pn < 16;
#pragma unroll
        for (int ai = 0; ai < 2; ++ai)
#pragma unroll
            for (int m = 0; m < 4; ++m) { const size_t row = (size_t)(row0 + ai * 128 + m * 16);
#pragma unroll
                for (int bj = 0; bj < 2; ++bj) { f32x4 v0 = acc[ai][bj][m][0], v1 = acc[ai][bj][m][1]; const int col = colt + bj * 128;
                    if (isz) {
#pragma unroll
                        for (int j = 0; j < 4; ++j) { v0[j] = gelu_tanh(v0[j]); v1[j] = gelu_tanh(v1[j]); }
                        u32x4 w; w.x = pk2(v0[0], v0[1]); w.y = pk2(v0[2], v0[3]); w.z = pk2(v1[0], v1[1]); w.w = pk2(v1[2], v1[3]);
                        *(u32x4*)(Z + row * DM + col) = w;
                    } else { const int c2 = col - 4096;
                        if (c2 < PSW) { u32x4 w; w.x = pk2(v0[0], v0[1]); w.y = pk2(v0[2], v0[3]); w.z = pk2(v1[0], v1[1]); w.w = pk2(v1[2], v1[3]);
                            *(u32x4*)(PS + row * PSW + c2) = w; } } } }
    }
};
__device__ __forceinline__ unsigned pkh2(float a, float b) { const _Float16 ha = (_Float16)a, hb = (_Float16)b; return (unsigned)__builtin_bit_cast(unsigned short, ha) | ((unsigned)__builtin_bit_cast(unsigned short, hb) << 16); }
__device__ __forceinline__ float decay_rate(float val) {
    const float xx = -val; const float sp = fmaxf(xx, 0.f) + __logf(1.0f + __expf(-fabsf(xx))); return __expf(-sp - 0.5f);
}
__device__ __forceinline__ float sigmoidf_(float v) { return 1.0f / (1.0f + __expf(-v)); }
struct EpiF16 {
    static constexpr bool PERM = true, AFTER_DRAIN = false;
    unsigned short* O;
    __device__ __forceinline__ void operator()(const f32x4 (&acc)[2][2][4][2], const pg8::Unit& u, int wr, int wc, int fr, int fq) const {
        const int row0 = u.pm * 256 + wr * 64 + fr, colt = u.pn * 256 + wc * 32 + 8 * fq;
#pragma unroll
        for (int ai = 0; ai < 2; ++ai)
#pragma unroll
            for (int m = 0; m < 4; ++m) { const size_t row = (size_t)(row0 + ai * 128 + m * 16);
#pragma unroll
                for (int bj = 0; bj < 2; ++bj) { const f32x4 v0 = acc[ai][bj][m][0], v1 = acc[ai][bj][m][1];
                    u32x4 w; w.x = pkh2(v0[0], v0[1]); w.y = pkh2(v0[2], v0[3]); w.z = pkh2(v1[0], v1[1]); w.w = pkh2(v1[2], v1[3]);
                    *(u32x4*)(O + row * LN_ + colt + bj * 128) = w; } }
    }
};
struct EpiNormPart {
    static constexpr bool PERM = true, AFTER_DRAIN = false;
    bf16_t* O; float* part;
    __device__ __forceinline__ void operator()(const f32x4 (&acc)[2][2][4][2], const pg8::Unit& u, int wr, int wc, int fr, int fq) const {
        const int row0 = u.pm * 256 + wr * 64 + fr, colt = u.pn * 256 + wc * 32 + 8 * fq;
#pragma unroll
        for (int ai = 0; ai < 2; ++ai)
#pragma unroll
            for (int m = 0; m < 4; ++m) { const size_t row = (size_t)(row0 + ai * 128 + m * 16); float s = 0.f;
#pragma unroll
                for (int bj = 0; bj < 2; ++bj) { const f32x4 v0 = acc[ai][bj][m][0], v1 = acc[ai][bj][m][1];
                    s += (v0[0] * v0[0] + v0[1] * v0[1]) + (v0[2] * v0[2] + v0[3] * v0[3]) + (v1[0] * v1[0] + v1[1] * v1[1]) + (v1[2] * v1[2] + v1[3] * v1[3]);
                    u32x4 w; w.x = pk2(v0[0], v0[1]); w.y = pk2(v0[2], v0[3]); w.z = pk2(v1[0], v1[1]); w.w = pk2(v1[2], v1[3]);
                    *(u32x4*)(O + row * DM + colt + bj * 128) = w; }
                s += __shfl_xor(s, 16); s += __shfl_xor(s, 32);
                if (fq == 0) part[row * 64 + u.pn * 4 + wc] = s; }
    }
};
struct EpiRelu2 {
    static constexpr bool PERM = true, AFTER_DRAIN = false;
    bf16_t* O;
    __device__ __forceinline__ void operator()(const f32x4 (&acc)[2][2][4][2], const pg8::Unit& u, int wr, int wc, int fr, int fq) const {
        const int row0 = u.pm * 256 + wr * 64 + fr, colt = u.pn * 256 + wc * 32 + 8 * fq;
#pragma unroll
        for (int ai = 0; ai < 2; ++ai)
#pragma unroll
            for (int m = 0; m < 4; ++m) { const size_t row = (size_t)(row0 + ai * 128 + m * 16);
#pragma unroll
                for (int bj = 0; bj < 2; ++bj) { f32x4 v0 = acc[ai][bj][m][0], v1 = acc[ai][bj][m][1];
#pragma unroll
                    for (int j = 0; j < 4; ++j) { const float a = fmaxf(v0[j], 0.f), b = fmaxf(v1[j], 0.f); v0[j] = a * a; v1[j] = b * b; }
                    u32x4 w; w.x = pk2(v0[0], v0[1]); w.y = pk2(v0[2], v0[3]); w.z = pk2(v1[0], v1[1]); w.w = pk2(v1[2], v1[3]);
                    *(u32x4*)(O + row * FFD + colt + bj * 128) = w; } }
    }
};

typedef const __attribute__((address_space(4))) Params* KP;
__device__ __forceinline__ KP kparams() { unsigned long long q = (unsigned long long)__builtin_amdgcn_kernarg_segment_ptr(); asm volatile("" : "+s"(q) :: "memory"); return (KP)q; }
__device__ __forceinline__ void transpose_item(const float* W, int K, int N, bf16_t* WT, LAS float* scr, int item, int lane) {
    const int nblk = N / 32, kb = item / nblk, nb = item % nblk, k0 = 64 * kb, n0 = 32 * nb;
#pragma unroll 8
    for (int i = 0; i < 32; ++i) { const int kk = 2 * i + (lane >> 5); scr[kk * 33 + (lane & 31)] = W[(size_t)(k0 + kk) * N + n0 + (lane & 31)]; }
    LDS_WAIT();
    const int c = lane & 7;
#pragma unroll
    for (int j = 0; j < 4; ++j) { const int n = (lane >> 3) + 8 * j; const LAS float* s = scr + (8 * c) * 33 + n;
        u32x4 o; o.x = pk2(s[0 * 33], s[1 * 33]); o.y = pk2(s[2 * 33], s[3 * 33]); o.z = pk2(s[4 * 33], s[5 * 33]); o.w = pk2(s[6 * 33], s[7 * 33]);
        *(u32x4*)(WT + (size_t)(n0 + n) * K + k0 + 8 * c) = o; }
    LDS_WAIT();
}

__device__ __forceinline__ void phase0(KP p, unsigned char* lds, int gw, int NGW, int lane, int wave) {
    unsigned char* ws = p->wsb;
    LAS float* scr = (LAS float*)((LAS unsigned char*)lds + wave * 8448);
    bf16_t* WinT = (bf16_t*)(ws + OFF_WIN); bf16_t* WoT = (bf16_t*)(ws + OFF_WOT); bf16_t* W1T = (bf16_t*)(ws + OFF_W1T); bf16_t* W2T = (bf16_t*)(ws + OFF_W2T);
    constexpr int I_IN = (DM / 64) * (NPROJ / 32), I_O = (DM / 64) * (DM / 32), I_1 = (DM / 64) * (FFD / 32), I_2 = (FFD / 64) * (DM / 32);
    constexpr int NITEMS = I_IN + I_O + I_1 + I_2;
    for (int it = gw; it < NITEMS; it += NGW) {
        int r = it;
        if (r < I_IN) { transpose_item(p->w_in, DM, NPROJ, WinT, scr, r, lane); continue; } r -= I_IN;
        if (r < I_O) { transpose_item(p->w_out, DM, DM, WoT, scr, r, lane); continue; } r -= I_O;
        if (r < I_1) { transpose_item(p->w_ff1, DM, FFD, W1T, scr, r, lane); continue; } r -= I_1;
        transpose_item(p->w_ff2, FFD, DM, W2T, scr, r, lane);
    }
    { u32x4* z = (u32x4*)(WinT + (size_t)NPROJ * DM); const size_t n16 = (size_t)(NPAD - NPROJ) * DM * 2 / 16; const u32x4 zero = {0u, 0u, 0u, 0u};
      for (size_t i = (size_t)gw * 64 + lane; i < n16; i += (size_t)NGW * 64) z[i] = zero; }
    { bf16_t* BT2 = (bf16_t*)(ws + OFF_BT2);
      for (size_t i = (size_t)gw * 64 + lane; i < (size_t)LN_ * LK; i += (size_t)NGW * 64) { const int n = (int)(i / LK), k = (int)(i % LK); float v = 0.f;
          if (n < 2048) { if (k < 64) v = p->w_up[(size_t)k * RW + n]; }
          else if (n < 4096) { if (k >= 64 && k < 128) v = p->a_up[(size_t)(k - 64) * RW + (n - 2048)]; }
          else { if (k >= 128) v = p->g_up[(size_t)(k - 128) * RW + (n - 4096)]; }
          BT2[i] = f2bf(v); } }
    bf16_t* H = (bf16_t*)(ws + OFF_H);
    for (int row = gw; row < M_TOK; row += NGW) {
        const float* gp0 = p->pre_mix_g; asm volatile("" : "+s"(gp0));
        const f32x4* xr = (const f32x4*)(p->x + (size_t)row * DM) + lane; f32x4 v[16]; float s = 0.f;
#pragma unroll
        for (int j = 0; j < 16; ++j) { v[j] = xr[64 * j]; s += (v[j].x * v[j].x + v[j].y * v[j].y) + (v[j].z * v[j].z + v[j].w * v[j].w); }
        const float rs = rsqrtf(wave_sum(s) * (1.0f / DM) + 1e-6f);
        u32x2* o = (u32x2*)(H + (size_t)row * DM) + lane;
#pragma unroll
        for (int j = 0; j < 16; ++j) { const f32x4 g = ((const f32x4*)gp0)[lane + 64 * j]; u32x2 w; w.x = pk2(v[j].x * rs * g.x, v[j].y * rs * g.y); w.y = pk2(v[j].z * rs * g.z, v[j].w * rs * g.w); o[64 * j] = w; }
    }
}

__device__ __forceinline__ void phase2(KP p, int gw, int NGW, int lane) {
    unsigned char* ws = p->wsb;
    const bf16_t* Z = (const bf16_t*)(ws + OFF_Z); const bf16_t* PS = (const bf16_t*)(ws + OFF_PS); bf16_t* A2 = (bf16_t*)(ws + OFF_A2); float* ST = (float*)(ws + OFF_ST);
    for (int row = gw; row < M_TOK; row += NGW) {
        const u32x4* zr = (const u32x4*)(Z + (size_t)row * DM + 2048) + lane; float v[32]; float s = 0.f;
#pragma unroll
        for (int j = 0; j < 4; ++j) { const u32x4 q = zr[64 * j];
            v[8 * j + 0] = bflo(q.x); v[8 * j + 1] = bfhi(q.x); v[8 * j + 2] = bflo(q.y); v[8 * j + 3] = bfhi(q.y); v[8 * j + 4] = bflo(q.z); v[8 * j + 5] = bfhi(q.z); v[8 * j + 6] = bflo(q.w); v[8 * j + 7] = bfhi(q.w); }
#pragma unroll
        for (int j = 0; j < 32; ++j) s += v[j];
        const float mean = wave_sum(s) * (1.0f / 2048.0f); float s2 = 0.f;
#pragma unroll
        for (int j = 0; j < 32; ++j) { const float d = v[j] - mean; s2 += d * d; }
        const float rstd = rsqrtf(wave_sum(s2) * (1.0f / 2048.0f) + 1e-5f);
        if (lane == 0) { ST[2 * row] = mean; ST[2 * row + 1] = rstd; }
        const bool has_prev = (row % T_SEQ) != 0;
#pragma unroll
        for (int i = 0; i < 6; ++i) { const int c = lane + 64 * i; const float cur = bf1(PS[(size_t)row * PSW + 6144 + c]);
            const float prev = has_prev ? bf1(PS[(size_t)(row - 1) * PSW + 6144 + c]) : 0.f; const float m = p->mu[6144 + c];
            float val = cur + (prev - cur) * m;
            if (i == 0) val = tanhf(val); else if (i >= 2) val = 1.0f / (1.0f + __expf(-val));
            A2[(size_t)row * LK + c] = f2bf(val); }
    }
}

__device__ __forceinline__ void phase_gmlp(KP p, unsigned char* ldsg, int tid, int lane, int wave) {
    unsigned char* ws = p->wsb;
    const bf16_t* Z = (const bf16_t*)(ws + OFF_Z); const float* ST = (const float*)(ws + OFF_ST); bf16_t* Y = (bf16_t*)(ws + OFF_Y);
    LAS bf16_t* Wm = (LAS bf16_t*)(LAS unsigned char*)ldsg; LAS bf16_t* Vt = Wm + 128 * 136;
    const int fr = lane & 15, fq = lane >> 4;
    for (int unit = blockIdx.x; unit < 2048; unit += gridDim.x) {
        const int h = unit & 15, bn = unit >> 4, tok0 = bn * 128;
        { const int i = tid >> 2, jb = (tid & 3) * 32; const f32x4* src = (const f32x4*)(p->ws + ((size_t)h * 128 + i) * 128 + jb); const bool keep = (jb >> 6) <= (i >> 6);
#pragma unroll
          for (int q = 0; q < 4; ++q) { f32x4 a = src[2 * q], b = src[2 * q + 1]; if (!keep) { a = (f32x4){0.f, 0.f, 0.f, 0.f}; b = a; }
              u32x4 o; o.x = pk2(a.x, a.y); o.y = pk2(a.z, a.w); o.z = pk2(b.x, b.y); o.w = pk2(b.z, b.w); *(LAS u32x4*)(Wm + i * 136 + jb + 8 * q) = o; } }
        { const int j = tid >> 2, cb = (tid & 3) * 32; const int tok = tok0 + j; const float mean = ST[2 * tok], rstd = ST[2 * tok + 1];
          const u32x4* src = (const u32x4*)(Z + (size_t)tok * DM + 2048 + h * 128 + cb);
#pragma unroll
          for (int q = 0; q < 4; ++q) { const u32x4 z8 = src[q]; float zf[8] = {bflo(z8.x), bfhi(z8.x), bflo(z8.y), bfhi(z8.y), bflo(z8.z), bfhi(z8.z), bflo(z8.w), bfhi(z8.w)};
              const f32x4 g0 = *(const f32x4*)(p->ln_g + h * 128 + cb + 8 * q), g1 = *(const f32x4*)(p->ln_g + h * 128 + cb + 8 * q + 4);
              const f32x4 b0 = *(const f32x4*)(p->ln_b + h * 128 + cb + 8 * q), b1 = *(const f32x4*)(p->ln_b + h * 128 + cb + 8 * q + 4);
#pragma unroll
              for (int e = 0; e < 8; ++e) { const float gg = e < 4 ? g0[e & 3] : g1[e & 3], bb = e < 4 ? b0[e & 3] : b1[e & 3];
                  Vt[(cb + 8 * q + e) * 136 + j] = f2bf((zf[e] - mean) * rstd * gg + bb); } } }
        __syncthreads();
        f32x4 acc[8];
#pragma unroll
        for (int ct = 0; ct < 8; ++ct) acc[ct] = (f32x4){0.f, 0.f, 0.f, 0.f};
        const int i0 = 16 * wave; const int nks = (wave < 4) ? 2 : 4;
        for (int ks = 0; ks < nks; ++ks) { const bf16x8 wf = *(const LAS bf16x8*)(Wm + (i0 + fr) * 136 + ks * 32 + fq * 8);
#pragma unroll
            for (int ct = 0; ct < 8; ++ct) { const bf16x8 vf = *(const LAS bf16x8*)(Vt + (ct * 16 + fr) * 136 + ks * 32 + fq * 8);
                acc[ct] = __builtin_amdgcn_mfma_f32_16x16x32_bf16(vf, wf, acc[ct], 0, 0, 0); } }
        { const int tok = tok0 + i0 + fr; const float bias = p->bs[h * 128 + i0 + fr];
#pragma unroll
          for (int ct = 0; ct < 8; ++ct) { const int c = h * 128 + ct * 16 + 4 * fq; const u32x2 uu = *(const u32x2*)(Z + (size_t)tok * DM + c);
              u32x2 o; o.x = pk2(bflo(uu.x) * (acc[ct][0] + bias), bfhi(uu.x) * (acc[ct][1] + bias)); o.y = pk2(bflo(uu.y) * (acc[ct][2] + bias), bfhi(uu.y) * (acc[ct][3] + bias));
              *(u32x2*)(Y + (size_t)tok * DM + c) = o; } }
        __syncthreads();
    }
}

constexpr int SC = 64;
constexpr int L_KK = 0, L_WW = 16384, L_BB = 32768, L_KP = 49152, L_RR = 65536, L_VV = 81920, L_YB = 86016;
__device__ __forceinline__ void phase_scan(KP p, unsigned char* ldsg, int tid, int lane, int wave) {
    unsigned char* ws = p->wsb;
    const bf16_t* PS = (const bf16_t*)(ws + OFF_PS); const _Float16* LO = (const _Float16*)(ws + OFF_LO); float* YR = (float*)(ws + OFF_YRAW);
    LAS unsigned char* lds = (LAS unsigned char*)ldsg;
    const int G = gridDim.x, bx = blockIdx.x; const int vcu = (G % 8 == 0) ? (bx % 8) * (G / 8) + bx / 8 : bx;
    for (int su = vcu; su < 256; su += G) {
        const int hp = su >> 2, q = su & 3, b = hp >> 5, h = hp & 31;
        f32x4 S = {0.f, 0.f, 0.f, 0.f};
        const int pt = tid >> 3, kb = (tid & 7) * 8, hc = h * 64 + kb;
        const int j = lane & 15, rl = wave * 4 + (lane >> 4);
        for (int t0 = 0; t0 < T_SEQ; t0 += SC) {
            {
                const size_t tok = (size_t)b * T_SEQ + t0 + pt; const bool hasp = (t0 + pt) > 0;
                const bf16_t* row = PS + tok * PSW + hc; const bf16_t* prow = row - PSW;
                const u32x4 zero = {0u, 0u, 0u, 0u};
                const u32x4 rc = *(const u32x4*)(row), kc = *(const u32x4*)(row + 2048), vc = *(const u32x4*)(row + 4096);
                const u32x4 rp = hasp ? *(const u32x4*)(prow) : zero, kp_ = hasp ? *(const u32x4*)(prow + 2048) : zero, vp = hasp ? *(const u32x4*)(prow + 4096) : zero;
                typedef _Float16 h8 __attribute__((ext_vector_type(8)));
                const h8 e8 = *(const h8*)(LO + tok * LN_ + hc); const h8 a8 = *(const h8*)(LO + tok * LN_ + 2048 + hc);
                float r[8], k[8], v[8], a[8], kk[8]; float ss = 0.f;
                const unsigned rcw[4] = {rc.x, rc.y, rc.z, rc.w}, rpw[4] = {rp.x, rp.y, rp.z, rp.w}, kcw[4] = {kc.x, kc.y, kc.z, kc.w}, kpw[4] = {kp_.x, kp_.y, kp_.z, kp_.w};
                const unsigned vcw[4] = {vc.x, vc.y, vc.z, vc.w}, vpw[4] = {vp.x, vp.y, vp.z, vp.w};
#pragma unroll
                for (int e = 0; e < 8; ++e) { const int wq = e >> 1; const bool hi = e & 1;
                    const float rcf = hi ? bfhi(rcw[wq]) : bflo(rcw[wq]), rpf = hi ? bfhi(rpw[wq]) : bflo(rpw[wq]);
                    const float kcf = hi ? bfhi(kcw[wq]) : bflo(kcw[wq]), kpf = hi ? bfhi(kpw[wq]) : bflo(kpw[wq]);
                    const float vcf = hi ? bfhi(vcw[wq]) : bflo(vcw[wq]), vpf = hi ? bfhi(vpw[wq]) : bflo(vpw[wq]);
                    r[e] = rcf + (rpf - rcf) * p->mu[hc + e]; k[e] = kcf + (kpf - kcf) * p->mu[2048 + hc + e]; v[e] = vcf + (vpf - vcf) * p->mu[4096 + hc + e];
                    a[e] = sigmoidf_(p->a0[hc + e] + (float)a8[e]);
                    kk[e] = k[e] * p->k_k[hc + e]; ss += kk[e] * kk[e]; }
                ss += __shfl_xor(ss, 1); ss += __shfl_xor(ss, 2); ss += __shfl_xor(ss, 4);
                const float inv = 1.0f / fmaxf(sqrtf(ss), 1e-12f);
                f32x4 o0, o1;
                LAS f32x4* dKK = (LAS f32x4*)(lds + L_KK + pt * 256 + kb * 4); LAS f32x4* dWW = (LAS f32x4*)(lds + L_WW + pt * 256 + kb * 4); LAS f32x4* dBB = (LAS f32x4*)(lds + L_BB + pt * 256 + kb * 4);
                LAS f32x4* dKP = (LAS f32x4*)(lds + L_KP + pt * 256 + kb * 4); LAS f32x4* dRR = (LAS f32x4*)(lds + L_RR + pt * 256 + kb * 4);
#pragma unroll
                for (int e = 0; e < 8; ++e) kk[e] *= inv;
                o0 = (f32x4){kk[0], kk[1], kk[2], kk[3]}; o1 = (f32x4){kk[4], kk[5], kk[6], kk[7]}; dKK[0] = o0; dKK[1] = o1;
                { float wv[8];
#pragma unroll
                for (int e = 0; e < 8; ++e) wv[e] = __expf(-decay_rate(p->w0[hc + e] + (float)e8[e]));
                o0 = (f32x4){wv[0], wv[1], wv[2], wv[3]}; o1 = (f32x4){wv[4], wv[5], wv[6], wv[7]}; dWW[0] = o0; dWW[1] = o1; }
                o0 = (f32x4){kk[0] * a[0], kk[1] * a[1], kk[2] * a[2], kk[3] * a[3]}; o1 = (f32x4){kk[4] * a[4], kk[5] * a[5], kk[6] * a[6], kk[7] * a[7]}; dBB[0] = o0; dBB[1] = o1;
                float kq[8];
#pragma unroll
                for (int e = 0; e < 8; ++e) kq[e] = k[e] * (1.0f + (a[e] - 1.0f) * p->k_a[hc + e]);
                o0 = (f32x4){kq[0], kq[1], kq[2], kq[3]}; o1 = (f32x4){kq[4], kq[5], kq[6], kq[7]}; dKP[0] = o0; dKP[1] = o1;
                o0 = (f32x4){r[0], r[1], r[2], r[3]}; o1 = (f32x4){r[4], r[5], r[6], r[7]}; dRR[0] = o0; dRR[1] = o1;
                if ((kb >> 4) == q) { LAS f32x4* dVV = (LAS f32x4*)(lds + L_VV + pt * 64 + (kb & 15) * 4); dVV[0] = (f32x4){v[0], v[1], v[2], v[3]}; dVV[1] = (f32x4){v[4], v[5], v[6], v[7]}; }
            }
            __syncthreads();
            if (wave < 4) {
                const LAS f32x4* pKK = (const LAS f32x4*)(lds + L_KK) + j; const LAS f32x4* pWW = (const LAS f32x4*)(lds + L_WW) + j; const LAS f32x4* pBB = (const LAS f32x4*)(lds + L_BB) + j;
                const LAS f32x4* pKP = (const LAS f32x4*)(lds + L_KP) + j; const LAS f32x4* pRR = (const LAS f32x4*)(lds + L_RR) + j;
                const LAS float* pVV = (const LAS float*)(lds + L_VV) + rl; LAS float* pYB = (LAS float*)(lds + L_YB) + rl;
#pragma unroll 4
                for (int t = 0; t < SC; ++t) {
                    const f32x4 kk4 = pKK[t * 16], w4 = pWW[t * 16], b4 = pBB[t * 16], k4 = pKP[t * 16], r4 = pRR[t * 16]; const float vv = pVV[t * 16];
                    float sa = (S.x * kk4.x + S.y * kk4.y) + (S.z * kk4.z + S.w * kk4.w);
                    sa = -red16(sa);
                    S.x = S.x * w4.x + (sa * b4.x + vv * k4.x); S.y = S.y * w4.y + (sa * b4.y + vv * k4.y);
                    S.z = S.z * w4.z + (sa * b4.z + vv * k4.z); S.w = S.w * w4.w + (sa * b4.w + vv * k4.w);
                    float y = (S.x * r4.x + S.y * r4.y) + (S.z * r4.z + S.w * r4.w);
                    y = red16(y);
                    if (j == 0) pYB[t * 16] = y;
                }
            }
            __syncthreads();
            if (tid < 256) { const int t = tid >> 2, c4 = tid & 3; const f32x4 yv = *(const LAS f32x4*)(lds + L_YB + t * 64 + c4 * 16);
                *(f32x4*)(YR + ((size_t)b * T_SEQ + t0 + t) * RW + h * 64 + q * 16 + c4 * 4) = yv; }
        }
        __syncthreads();
    }
}

__device__ __forceinline__ void phase_post(KP p, int gw, int NGW, int lane) {
    unsigned char* ws = p->wsb;
    const bf16_t* PS = (const bf16_t*)(ws + OFF_PS); const _Float16* LO = (const _Float16*)(ws + OFF_LO); const float* YR = (const float*)(ws + OFF_YRAW); bf16_t* Y = (bf16_t*)(ws + OFF_Y);
    for (int tok = gw; tok < M_TOK; tok += NGW) {
        const bool hasp = (tok % T_SEQ) != 0;
        const bf16_t* row = PS + (size_t)tok * PSW; const bf16_t* prow = row - PSW;
        for (int hg = 0; hg < 8; ++hg) { const int col = hg * 256 + lane * 4;
            const f32x4 y = *(const f32x4*)(YR + (size_t)tok * RW + col);
            const u32x2 z2 = {0u, 0u};
            const u32x2 rc = *(const u32x2*)(row + col), kc = *(const u32x2*)(row + 2048 + col), vc = *(const u32x2*)(row + 4096 + col);
            const u32x2 rp = hasp ? *(const u32x2*)(prow + col) : z2, kp = hasp ? *(const u32x2*)(prow + 2048 + col) : z2, vp = hasp ? *(const u32x2*)(prow + 4096 + col) : z2;
            const f32x4 mur = *(const f32x4*)(p->mu + col), muk = *(const f32x4*)(p->mu + 2048 + col), muv = *(const f32x4*)(p->mu + 4096 + col);
            typedef _Float16 h4 __attribute__((ext_vector_type(4))); const h4 a2 = *(const h4*)(LO + (size_t)tok * LN_ + 2048 + col), g2 = *(const h4*)(LO + (size_t)tok * LN_ + 4096 + col); const f32x4 a0v = *(const f32x4*)(p->a0 + col);
            const f32x4 ka = *(const f32x4*)(p->k_a + col), rk = *(const f32x4*)(p->r_k + col), lg = *(const f32x4*)(p->lnx_g + col), lb = *(const f32x4*)(p->lnx_b + col);
            const f32x4 rcf = {bflo(rc.x), bfhi(rc.x), bflo(rc.y), bfhi(rc.y)}, rpf = {bflo(rp.x), bfhi(rp.x), bflo(rp.y), bfhi(rp.y)};
            const f32x4 kcf = {bflo(kc.x), bfhi(kc.x), bflo(kc.y), bfhi(kc.y)}, kpf = {bflo(kp.x), bfhi(kp.x), bflo(kp.y), bfhi(kp.y)};
            const f32x4 vcf = {bflo(vc.x), bfhi(vc.x), bflo(vc.y), bfhi(vc.y)}, vpf = {bflo(vp.x), bfhi(vp.x), bflo(vp.y), bfhi(vp.y)};
            const f32x4 af = {sigmoidf_(a0v.x + (float)a2[0]), sigmoidf_(a0v.y + (float)a2[1]), sigmoidf_(a0v.z + (float)a2[2]), sigmoidf_(a0v.w + (float)a2[3])}, gf = {(float)g2[0], (float)g2[1], (float)g2[2], (float)g2[3]};
            const f32x4 r = rcf + (rpf - rcf) * mur, k = kcf + (kpf - kcf) * muk, v = vcf + (vpf - vcf) * muv;
            const f32x4 kq = k * (1.0f + (af - 1.0f) * ka);
            const f32x4 rkk = r * kq * rk;
            const float bonus = red16((rkk.x + rkk.y) + (rkk.z + rkk.w));
            const float mean = red16((y.x + y.y) + (y.z + y.w)) * (1.0f / 64.0f);
            const f32x4 d = y - mean;
            const float var = red16((d.x * d.x + d.y * d.y) + (d.z * d.z + d.w * d.w)) * (1.0f / 64.0f);
            const float rstd = rsqrtf(var + 64e-5f);
            const f32x4 o = ((d * rstd) * lg + lb + bonus * v) * gf;
            u32x2 w; w.x = pk2(o.x, o.y); w.y = pk2(o.z, o.w);
            *(u32x2*)(Y + (size_t)tok * DM + 2048 + col) = w; }
    }
}

__device__ __forceinline__ void phase7(KP p, int gw, int NGW, int lane) {
    unsigned char* ws = p->wsb;
    const bf16_t* MIX = (const bf16_t*)(ws + OFF_MIX); const float* SS = (const float*)(ws + OFF_SS1); bf16_t* H = (bf16_t*)(ws + OFF_H);
    for (int row = gw; row < M_TOK; row += NGW) {
        const float* gp1 = p->post_mix_g; const float* gp2 = p->pre_ffn_g; asm volatile("" : "+s"(gp1), "+s"(gp2));
        const float rs1 = rsqrtf(wave_sum(SS[(size_t)row * 64 + lane]) * (1.0f / DM) + 1e-6f);
        const f32x4* xr = (const f32x4*)(p->x + (size_t)row * DM) + lane; const u32x2* mr = (const u32x2*)(MIX + (size_t)row * DM) + lane;
        f32x4* orow = (f32x4*)(p->out + (size_t)row * DM) + lane; u32x2* hrow = (u32x2*)(H + (size_t)row * DM) + lane;
        float s = 0.f;
#pragma unroll 4
        for (int j = 0; j < 16; ++j) { const f32x4 xx = xr[64 * j]; const u32x2 mm = mr[64 * j]; const f32x4 g = ((const f32x4*)gp1)[lane + 64 * j];
            const f32x4 mf = {bflo(mm.x), bfhi(mm.x), bflo(mm.y), bfhi(mm.y)};
            const f32x4 v = xx + (mf * rs1) * g; s += (v.x * v.x + v.y * v.y) + (v.z * v.z + v.w * v.w); orow[64 * j] = v; }
        const float rs2 = rsqrtf(wave_sum(s) * (1.0f / DM) + 1e-6f);
        asm volatile("s_waitcnt vmcnt(0)" ::: "memory");
#pragma unroll 4
        for (int j = 0; j < 16; ++j) { const f32x4 g = ((const f32x4*)gp2)[lane + 64 * j]; const f32x4 v = orow[64 * j];
            u32x2 w; w.x = pk2(v.x * rs2 * g.x, v.y * rs2 * g.y); w.y = pk2(v.z * rs2 * g.z, v.w * rs2 * g.w); hrow[64 * j] = w; }
    }
}
__device__ __forceinline__ void phase10(KP p, int gw, int NGW, int lane) {
    unsigned char* ws = p->wsb;
    const bf16_t* F = (const bf16_t*)(ws + OFF_F); const float* SS = (const float*)(ws + OFF_SS2);
    for (int row = gw; row < M_TOK; row += NGW) {
        const float* gp3 = p->post_ffn_g; asm volatile("" : "+s"(gp3));
        const float rs = rsqrtf(wave_sum(SS[(size_t)row * 64 + lane]) * (1.0f / DM) + 1e-6f);
        f32x4* orow = (f32x4*)(p->out + (size_t)row * DM) + lane; const u32x2* fr_ = (const u32x2*)(F + (size_t)row * DM) + lane;
#pragma unroll
        for (int j = 0; j < 16; ++j) { const f32x4 xx = orow[64 * j]; const u32x2 mm = fr_[64 * j]; const f32x4 g = ((const f32x4*)gp3)[lane + 64 * j];
            const f32x4 mf = {bflo(mm.x), bfhi(mm.x), bflo(mm.y), bfhi(mm.y)};
            orow[64 * j] = xx + (mf * rs) * g; }
    }
}

constexpr int NPHASE = 11;
__global__ void __launch_bounds__(NTHREADS, 2) fwd_megakernel(Params p_) {
    extern __shared__ __attribute__((aligned(16))) unsigned char lds[];
    const int tid = threadIdx.x, lane = tid & 63, wave = __builtin_amdgcn_readfirstlane(tid >> 6);
    const int G = gridDim.x, gw = blockIdx.x * NWAVES + wave, NGW = G * NWAVES;
    const int lo = p_.ph_lo, hi = p_.ph_hi;
#ifndef PH_MASK
#define PH_MASK 0x7ff
#endif
#define IN(k) ((((PH_MASK) >> (k)) & 1) && lo <= (k) && (k) < hi)
#define SEAM(k) do { if (IN(k) && IN((k) + 1)) { cg::this_grid().sync(); } } while (0)
    if (IN(0)) { KP p = kparams(); phase0(p, lds, gw, NGW, lane, wave); } SEAM(0);
    if (IN(1)) { KP p = kparams(); unsigned char* ws = p->wsb; pg8::Gemm g{(const bf16_t*)(ws + OFF_H), (const bf16_t*)(ws + OFF_WIN), M_TOK, NPAD, DM}; pg8::StaticOrder S; S.init(M_TOK, NPAD, G, (int)blockIdx.x);
        EpiProj E{(bf16_t*)(ws + OFF_Z), (bf16_t*)(ws + OFF_PS)};
        pg8::gemm_phase<EpiProj, pg8::StaticOrder>((PG8_LAS unsigned char*)lds, g, S, E, nullptr); } SEAM(1);
    if (IN(2)) { KP p = kparams(); phase2(p, gw, NGW, lane); } SEAM(2);
    if (IN(3)) { KP p = kparams(); unsigned char* ws = p->wsb; { pg8::Gemm g{(const bf16_t*)(ws + OFF_A2), (const bf16_t*)(ws + OFF_BT2), M_TOK, LN_, LK}; pg8::StaticOrder S; S.init(M_TOK, LN_, G, (int)blockIdx.x);
          EpiF16 E{(unsigned short*)(ws + OFF_LO)};
          pg8::gemm_phase<EpiF16, pg8::StaticOrder>((PG8_LAS unsigned char*)lds, g, S, E, nullptr); }
        __syncthreads();
        phase_gmlp(p, lds, tid, lane, wave); } SEAM(3);
    if (IN(4)) { KP p = kparams(); phase_scan(p, lds, tid, lane, wave); } SEAM(4);
    if (IN(5)) { KP p = kparams(); phase_post(p, gw, NGW, lane); } SEAM(5);
    if (IN(6)) { KP p = kparams(); unsigned char* ws = p->wsb; pg8::Gemm g{(const bf16_t*)(ws + OFF_Y), (const bf16_t*)(ws + OFF_WOT), M_TOK, DM, DM}; pg8::StaticOrder S; S.init(M_TOK, DM, G, (int)blockIdx.x);
        EpiNormPart E{(bf16_t*)(ws + OFF_MIX), (float*)(ws + OFF_SS1)};
        pg8::gemm_phase<EpiNormPart, pg8::StaticOrder>((PG8_LAS unsigned char*)lds, g, S, E, nullptr); } SEAM(6);
    if (IN(7)) { KP p = kparams(); phase7(p, gw, NGW, lane); } SEAM(7);
    if (IN(8)) { KP p = kparams(); unsigned char* ws = p->wsb; pg8::Gemm g{(const bf16_t*)(ws + OFF_H), (const bf16_t*)(ws + OFF_W1T), M_TOK, FFD, DM}; pg8::StaticOrder S; S.init(M_TOK, FFD, G, (int)blockIdx.x);
        EpiRelu2 E{(bf16_t*)(ws + OFF_HID)};
        pg8::gemm_phase<EpiRelu2, pg8::StaticOrder>((PG8_LAS unsigned char*)lds, g, S, E, nullptr); } SEAM(8);
    if (IN(9)) { KP p = kparams(); unsigned char* ws = p->wsb; pg8::Gemm g{(const bf16_t*)(ws + OFF_HID), (const bf16_t*)(ws + OFF_W2T), M_TOK, DM, FFD}; pg8::StaticOrder S; S.init(M_TOK, DM, G, (int)blockIdx.x);
        EpiNormPart E{(bf16_t*)(ws + OFF_F), (float*)(ws + OFF_SS2)};
        pg8::gemm_phase<EpiNormPart, pg8::StaticOrder>((PG8_LAS unsigned char*)lds, g, S, E, nullptr); } SEAM(9);
    if (IN(10)) { KP p = kparams(); phase10(p, gw, NGW, lane); }
#undef IN
#undef SEAM
}

#ifndef N_LAUNCH_MODE
#define N_LAUNCH_MODE 0
#endif
extern "C" void kernel_launch(void* const* d_in, const int* in_sizes, int n_in, void* d_out, int out_size, void* d_ws, size_t ws_size, hipStream_t stream) {
    static int grid = 0;
    if (grid == 0) {
        int dev = 0, cus = 0, per_cu = 0;
        (void)hipGetDevice(&dev); (void)hipDeviceGetAttribute(&cus, hipDeviceAttributeMultiprocessorCount, dev);
        if (hipFuncSetAttribute((const void*)fwd_megakernel, hipFuncAttributeMaxDynamicSharedMemorySize, LDS_BYTES) != hipSuccess) fprintf(stderr, "hipFuncSetAttribute failed\n");
        if (hipOccupancyMaxActiveBlocksPerMultiprocessor(&per_cu, (const void*)fwd_megakernel, NTHREADS, LDS_BYTES) != hipSuccess || per_cu < 1) { fprintf(stderr, "occupancy query: %d\n", per_cu); per_cu = 1; }
        (void)hipGetLastError();
        grid = cus * 1;
        if (n_in != 24 || ws_size < WS_END) fprintf(stderr, "unexpected n_in %d / ws_size %zu (need %zu)\n", n_in, ws_size, (size_t)WS_END);
    }
    Params p{};
    const float** pp = (const float**)&p;
    for (int i = 0; i < 24; ++i) pp[i] = (const float*)d_in[i];
    p.out = (float*)d_out; p.wsb = (unsigned char*)d_ws; p.pad = 0;
#if N_LAUNCH_MODE == 1
    p.ph_lo = 0; p.ph_hi = NPHASE; p.coop = 1;
    void* args[] = {&p};
    hipError_t e = hipLaunchCooperativeKernel((const void*)fwd_megakernel, dim3(grid), dim3(NTHREADS), args, LDS_BYTES, stream);
    if (e != hipSuccess) fprintf(stderr, "cooperative launch failed: %s (grid %d)\n", hipGetErrorString(e), grid);
#else
    for (int ph = 0; ph < NPHASE; ++ph) { p.ph_lo = ph; p.ph_hi = ph + 1; p.coop = 0;
        hipLaunchKernelGGL(fwd_megakernel, dim3(grid), dim3(NTHREADS), LDS_BYTES, stream, p); }
#endif
}
```

```cpp
#include <hip/hip_runtime.h>
#include <hip/hip_cooperative_groups.h>
#include <cstdio>
namespace cg = cooperative_groups;
namespace pg8 {
#define PG8_LAS __attribute__((address_space(3)))
typedef unsigned short bf16_t;
typedef short bf16x8 __attribute__((ext_vector_type(8)));
typedef float f32x4 __attribute__((ext_vector_type(4)));
typedef unsigned u32x4 __attribute__((ext_vector_type(4)));
constexpr int BM = 256, BK = 64, HALF = 128, HTB = HALF * BK * 2  , STAGE_BYTES = 8 * HTB, NXCD = 8, WGM = 8;

__host__ __device__ __forceinline__ int lds_byte(int r, int c) { const int st = (r >> 4) * 2 + (c >> 5), rr = r & 15, cc = c & 31, ob = rr * 64 + cc * 2; return st * 1024 + (ob ^ (((ob >> 9) & 1) << 5)); }
__host__ __device__ __forceinline__ void stage_rc(int b, int& R, int& C) { const int st = b / 1024, sb = b % 1024, swz = sb ^ (((sb >> 9) & 1) << 5); R = (st >> 1) * 16 + swz / 64; C = (st & 1) * 32 + (swz % 64) / 2; }
__host__ __device__ __forceinline__ int perm32(int rho) { const int n = rho >> 4, i = rho & 15; return 8 * (i >> 2) + 4 * n + (i & 3); }

struct Unit { int pm, pn; };
struct Gemm { const bf16_t* A; const bf16_t* Bt; int M, N, K; };

struct StaticOrder {
    int nM, nN, nwg, G, c;
    __host__ __device__ void init(int M, int N, int G_, int c_) { nM = M / BM; nN = N / BM; nwg = nM * nN; G = G_; c = c_; }
    __host__ __device__ bool next(int i, Unit& u) const {
        const long L = (long)i * G + c; if (L >= nwg) return false;
        int wgid = (int)L; { const int q = nwg / NXCD, r = nwg % NXCD, xcd = wgid % NXCD, off = wgid / NXCD; wgid = (xcd < r ? xcd * (q + 1) : r * (q + 1) + (xcd - r) * q) + off; }
        const int nig = WGM * nN, gid = wgid / nig, fm = gid * WGM, gsz = (nM - fm) < WGM ? (nM - fm) : WGM;
        u.pm = fm + ((wgid % nig) % gsz); u.pn = (wgid % nig) / gsz; return true;
    }
    __device__ __forceinline__ void a_ready(const Unit&) const {}
    __device__ __forceinline__ void done(const Unit&) const {}
};
__device__ __forceinline__ unsigned cvt_pk_bf16(float lo, float hi) { unsigned r; asm volatile("v_cvt_pk_bf16_f32 %0, %1, %2" : "=v"(r) : "v"(lo), "v"(hi)); return r; }
typedef float f32x2 __attribute__((ext_vector_type(2)));
template <class Epi, class Sched, bool STAMP = false>
__device__ __forceinline__ void gemm_phase(PG8_LAS unsigned char* lds, const Gemm g, const Sched& S, const Epi& E, unsigned long long* stamps) {
    const int tid = threadIdx.x, wid = __builtin_amdgcn_readfirstlane(tid >> 6), lane = tid & 63, wr = wid >> 2, wc = wid & 3, fr = lane & 15, fq = lane >> 4;
    const int K = g.K, nt = K / BK;
    int ts_lo = 0, ts_hi = 0, nts = 0; const unsigned long long rt_entry = STAMP ? (unsigned long long)wall_clock64() : 0ull;
#define PG8_STAMP() do { if (STAMP && wid == 0 && nts < 64) { const unsigned long long _c = (unsigned long long)clock64(); \
        ts_lo = (lane == nts) ? (int)(unsigned)_c : ts_lo; ts_hi = (lane == nts) ? (int)(unsigned)(_c >> 32) : ts_hi; ++nts; } } while (0)
    PG8_STAMP();
    unsigned voffA[2], voffB[2];
#pragma unroll
    for (int i = 0; i < 2; ++i) { int R, C; stage_rc(tid * 16 + i * 8192, R, C); const int Rb = Epi::PERM ? ((R & ~31) + perm32(R & 31)) : R;
        voffA[i] = (unsigned)(R * K + C) * 2u; voffB[i] = (unsigned)(Rb * K + C) * 2u; }
    const size_t kstep = (size_t)(BK * 2);
    const size_t hstep = (size_t)HALF * K * 2;
    const size_t tstep = 2 * hstep;
    const unsigned ldsw = (unsigned)wid * 1024u;
    const int aoff = lds_byte(wr * 64 + fr, fq * 8), boff = lds_byte(wc * 32 + fr, fq * 8);
#define PG8_SA(b, h) (((b) * 2 + (h)) * HTB)
#define PG8_SB(b, h) ((4 + (b) * 2 + (h)) * HTB)
#define PG8_STAGE(bufoff, gbase, voff) do { _Pragma("unroll") for (int _i = 0; _i < 2; ++_i) \
        __builtin_amdgcn_global_load_lds((const unsigned*)((const char*)(gbase) + (voff)[_i]), (PG8_LAS unsigned*)(lds + (bufoff) + ldsw + _i * 8192), 16, 0, 0); } while (0)
#define PG8_LDA(dst, b, h) do { _Pragma("unroll") for (int m = 0; m < 4; ++m) _Pragma("unroll") for (int k = 0; k < 2; ++k) dst[m][k] = *(const PG8_LAS bf16x8*)(lds + PG8_SA(b, h) + aoff + m * 2048 + k * 1024); } while (0)
#define PG8_LDB(dst, b, h) do { _Pragma("unroll") for (int n = 0; n < 2; ++n) _Pragma("unroll") for (int k = 0; k < 2; ++k) dst[n][k] = *(const PG8_LAS bf16x8*)(lds + PG8_SB(b, h) + boff + n * 2048 + k * 1024); } while (0)
#define PG8_MMA(ai, bj, At, Bt) do { __builtin_amdgcn_s_setprio(1); _Pragma("unroll") for (int m = 0; m < 4; ++m) _Pragma("unroll") for (int n = 0; n < 2; ++n) _Pragma("unroll") for (int k = 0; k < 2; ++k) \
        acc[ai][bj][m][n] = __builtin_amdgcn_mfma_f32_16x16x32_bf16(Bt[n][k], At[m][k], acc[ai][bj][m][n], 0, 0, 0); __builtin_amdgcn_s_setprio(0); } while (0)
#define PG8_WAIT_V(n) asm volatile("s_waitcnt vmcnt(" #n ")" ::: "memory")
#define PG8_WAIT_L(n) asm volatile("s_waitcnt lgkmcnt(" #n ")" ::: "memory")
#define PG8_BAR __builtin_amdgcn_s_barrier()
#define PG8_SCHED __builtin_amdgcn_sched_barrier(0)
    Unit cur, nxt; int ui = 0;
    if (!S.next(0, cur)) return;
    f32x4 acc[2][2][4][2];
#pragma unroll
    for (int a = 0; a < 2; ++a)
#pragma unroll
        for (int b = 0; b < 2; ++b)
#pragma unroll
            for (int m = 0; m < 4; ++m)
#pragma unroll
                for (int n = 0; n < 2; ++n) acc[a][b][m][n] = (f32x4){0.f, 0.f, 0.f, 0.f};
    bf16x8 At[4][2], B0[2][2], B1[2][2];
    const char* cA = (const char*)g.A + (size_t)cur.pm * tstep; const char* cB = (const char*)g.Bt + (size_t)cur.pn * tstep;
    S.a_ready(cur);
    PG8_STAGE(PG8_SB(0, 0), cB, voffB); PG8_STAGE(PG8_SA(0, 0), cA, voffA); PG8_STAGE(PG8_SB(0, 1), cB + hstep, voffB); PG8_STAGE(PG8_SA(0, 1), cA + hstep, voffA);
    if (wr == 1) PG8_BAR;
    PG8_WAIT_V(4); PG8_BAR;
    PG8_STAGE(PG8_SB(1, 0), cB + kstep, voffB); PG8_STAGE(PG8_SA(1, 0), cA + kstep, voffA); PG8_STAGE(PG8_SB(1, 1), cB + hstep + kstep, voffB);
    PG8_WAIT_V(6); PG8_BAR;
    PG8_STAMP();
    for (;;) {
        const bool has_next = S.next(ui + 1, nxt);
        const char* nA = has_next ? (const char*)g.A + (size_t)nxt.pm * tstep : cA; const char* nB = has_next ? (const char*)g.Bt + (size_t)nxt.pn * tstep : cB;
#pragma unroll 1
        for (int t = 0; t < nt; t += 2) {
            const bool last = (t == nt - 2);
            const char* a1 = cA + (size_t)(t + 1) * kstep;
            const char* a2 = last ? nA : cA + (size_t)(t + 2) * kstep; const char* b2 = last ? nB : cB + (size_t)(t + 2) * kstep;
            const char* a3 = a2 + kstep; const char* b3 = b2 + kstep;
            if (last && has_next) S.a_ready(nxt);
            PG8_LDB(B0, 0, 0); PG8_SCHED; PG8_LDA(At, 0, 0); PG8_STAGE(PG8_SA(1, 1), a1 + hstep, voffA);
            PG8_WAIT_L(8); PG8_BAR; PG8_WAIT_L(0); PG8_MMA(0, 0, At, B0); PG8_BAR; PG8_SCHED;
            PG8_LDB(B1, 0, 1); PG8_STAGE(PG8_SB(0, 0), b2, voffB);
            PG8_BAR; PG8_WAIT_L(0); PG8_MMA(0, 1, At, B1); PG8_BAR;
            PG8_LDA(At, 0, 1); PG8_STAGE(PG8_SA(0, 0), a2, voffA);
            PG8_BAR; PG8_WAIT_L(0); PG8_MMA(1, 0, At, B0); PG8_BAR; PG8_SCHED;
            PG8_STAGE(PG8_SB(0, 1), b2 + hstep, voffB);
            PG8_WAIT_V(6); PG8_BAR; PG8_MMA(1, 1, At, B1); PG8_BAR;
            PG8_LDB(B0, 1, 0); PG8_SCHED; PG8_LDA(At, 1, 0); PG8_STAGE(PG8_SA(0, 1), a2 + hstep, voffA);
            PG8_WAIT_L(8); PG8_BAR; PG8_WAIT_L(0); PG8_MMA(0, 0, At, B0); PG8_BAR; PG8_SCHED;
            PG8_LDB(B1, 1, 1); PG8_STAGE(PG8_SB(1, 0), b3, voffB);
            PG8_BAR; PG8_WAIT_L(0); PG8_MMA(0, 1, At, B1); PG8_BAR;
            PG8_LDA(At, 1, 1); PG8_STAGE(PG8_SA(1, 0), a3, voffA);
            PG8_BAR; PG8_WAIT_L(0); PG8_MMA(1, 0, At, B0); PG8_BAR; PG8_SCHED;
            PG8_STAGE(PG8_SB(1, 1), b3 + hstep, voffB);
            PG8_WAIT_V(6); PG8_BAR; PG8_MMA(1, 1, At, B1); PG8_BAR;
        }
        PG8_STAMP();
        if constexpr (!Epi::AFTER_DRAIN) { E(acc, cur, wr, wc, fr, fq); S.done(cur); }
        PG8_STAMP();
        if (!has_next) break;
#pragma unroll
        for (int a = 0; a < 2; ++a)
#pragma unroll
            for (int b = 0; b < 2; ++b)
#pragma unroll
                for (int m = 0; m < 4; ++m)
#pragma unroll
                    for (int n = 0; n < 2; ++n) acc[a][b][m][n] = (f32x4){0.f, 0.f, 0.f, 0.f};
        cur = nxt; cA = nA; cB = nB; ++ui;
    }
    PG8_WAIT_V(0);
    if (wr == 0) PG8_BAR;
    PG8_BAR;
    if constexpr (Epi::AFTER_DRAIN) { E.fused(acc, cur, wr, wc, fr, fq, lds, wid, lane); S.done(cur); }
    PG8_STAMP();
    if (STAMP && wid == 0) { stamps[lane] = lane < nts ? (((unsigned long long)(unsigned)ts_hi << 32) | (unsigned)ts_lo) : 0ull;
        if (lane == 62) stamps[62] = rt_entry; if (lane == 63) stamps[63] = (unsigned long long)wall_clock64(); }
#undef PG8_STAMP
#undef PG8_SA
#undef PG8_SB
#undef PG8_STAGE
#undef PG8_LDA
#undef PG8_LDB
#undef PG8_MMA
#undef PG8_WAIT_V
#undef PG8_WAIT_L
#undef PG8_BAR
#undef PG8_SCHED
}
}

#define LAS __attribute__((address_space(3)))
typedef unsigned short bf16_t;
typedef short bf16x8 __attribute__((ext_vector_type(8)));
typedef float f32x4 __attribute__((ext_vector_type(4)));
typedef unsigned u32x4 __attribute__((ext_vector_type(4)));
typedef unsigned u32x2 __attribute__((ext_vector_type(2)));

constexpr int M_TOK = 16384, T_SEQ = 8192, DM = 4096, NPROJ = 10624, NPAD = 10752, FFD = 16384;
constexpr int GW = 2048, RW = 2048, PSW = 6528, LK = 384, LN_ = 6144;
constexpr int LDS_BYTES = 151568, NTHREADS = 512, NWAVES = 8;

constexpr size_t OFF_W1T = 0;
constexpr size_t OFF_W2T = OFF_W1T + (size_t)FFD * DM * 2;
constexpr size_t OFF_WOT = OFF_W2T + (size_t)FFD * DM * 2;
constexpr size_t OFF_BT2 = OFF_WOT + (size_t)DM * DM * 2;
constexpr size_t OFF_H   = OFF_BT2 + (size_t)LN_ * LK * 2;
constexpr size_t OFF_WIN = OFF_H + (size_t)M_TOK * DM * 2;
constexpr size_t OFF_Z   = OFF_WIN + (size_t)NPAD * DM * 2;
constexpr size_t OFF_PS  = OFF_Z + (size_t)M_TOK * DM * 2;
constexpr size_t OFF_Y   = OFF_PS + (size_t)M_TOK * PSW * 2;
constexpr size_t OFF_A2  = OFF_Y + (size_t)M_TOK * DM * 2;
constexpr size_t OFF_ST  = OFF_A2 + (size_t)M_TOK * LK * 2;
constexpr size_t OFF_SS1 = OFF_ST + (size_t)M_TOK * 8;
constexpr size_t OFF_SS2 = OFF_SS1 + (size_t)M_TOK * 64 * 4;
constexpr size_t OFF_BAR = OFF_SS2 + (size_t)M_TOK * 64 * 4;
constexpr size_t WS_END  = OFF_BAR + 16384;
constexpr size_t OFF_LO  = OFF_H;
constexpr size_t OFF_YRAW = OFF_Z;
constexpr size_t OFF_MIX = OFF_PS;
constexpr size_t OFF_HID = OFF_WIN;
constexpr size_t OFF_F   = OFF_H;
static_assert(OFF_HID + (size_t)M_TOK * FFD * 2 <= OFF_A2, "hid overflows");
static_assert(OFF_LO + (size_t)M_TOK * LN_ * 2 <= OFF_Z, "LO fits H + WinT");
static_assert(WS_END <= (size_t)1073741824, "workspace");

struct Params {
    const float* x; const float* pre_mix_g; const float* w_in; const float* mu; const float* ln_g; const float* ln_b;
    const float* ws; const float* bs; const float* w0; const float* w_up; const float* a0; const float* a_up; const float* g_up;
    const float* k_k; const float* k_a; const float* r_k; const float* lnx_g; const float* lnx_b; const float* w_out;
    const float* post_mix_g; const float* pre_ffn_g; const float* w_ff1; const float* w_ff2; const float* post_ffn_g;
    float* out; unsigned char* wsb; int ph_lo, ph_hi, coop, pad;
};

typedef float f32x2v_ __attribute__((ext_vector_type(2))); typedef __bf16 bf16x2v_ __attribute__((ext_vector_type(2)));
__device__ __forceinline__ unsigned pk2(float lo, float hi) { const f32x2v_ v = {lo, hi}; return __builtin_bit_cast(unsigned, __builtin_convertvector(v, bf16x2v_)); }
__device__ __forceinline__ float bflo(unsigned u) { return __uint_as_float(u << 16); }
__device__ __forceinline__ float bfhi(unsigned u) { return __uint_as_float(u & 0xffff0000u); }
__device__ __forceinline__ float bf1(bf16_t b) { return __uint_as_float(((unsigned)b) << 16); }
__device__ __forceinline__ bf16_t f2bf(float f) { return (bf16_t)(pk2(f, 0.f) & 0xffffu); }
__device__ __forceinline__ float wave_sum(float v) {
#pragma unroll
    for (int o = 1; o < 64; o <<= 1) v += __shfl_xor(v, o);
    return v;
}
template <int CTRL> __device__ __forceinline__ float dpp_mov(float x) { return __builtin_bit_cast(float, __builtin_amdgcn_update_dpp(0, __builtin_bit_cast(int, x), CTRL, 0xf, 0xf, true)); }
__device__ __forceinline__ float red16(float v) {
    v += dpp_mov<0xB1>(v);
    v += dpp_mov<0x4E>(v);
    v += dpp_mov<0x141>(v);
    v += dpp_mov<0x140>(v);
    return v;
}
#define LDS_WAIT() asm volatile("s_waitcnt lgkmcnt(0)" ::: "memory")

__device__ __forceinline__ float gelu_tanh(float x) {
    const float u = 0.7978845608028654f * (x + 0.044715f * x * x * x);
    const float e = __builtin_amdgcn_exp2f(-2.0f * 1.4426950408889634f * u);
    return x * __builtin_amdgcn_rcpf(1.0f + e);
}
struct EpiProj {
    static constexpr bool PERM = true, AFTER_DRAIN = false;
    bf16_t* Z; bf16_t* PS;
    __device__ __forceinline__ void operator()(const f32x4 (&acc)[2][2][4][2], const pg8::Unit& u, int wr, int wc, int fr, int fq) const {
        const int row0 = u.pm * 256 + wr * 64 + fr, colt = u.pn * 256 + wc * 32 + 8 * fq;
        const bool isz = u.pn < 16;
#pragma unroll
        for (int ai = 0; ai < 2; ++ai)
#pragma unroll
            for (int m = 0; m < 4; ++m) { const size_t row = (size_t)(row0 + ai * 128 + m * 16);
#pragma unroll
                for (int bj = 0; bj < 2; ++bj) { f32x4 v0 = acc[ai][bj][m][0], v1 = acc[ai][bj][m][1]; const int col = colt + bj * 128;
                    if (isz) {
#pragma unroll
                        for (int j = 0; j < 4; ++j) { v0[j] = gelu_tanh(v0[j]); v1[j] = gelu_tanh(v1[j]); }
                        u32x4 w; w.x = pk2(v0[0], v0[1]); w.y = pk2(v0[2], v0[3]); w.z = pk2(v1[0], v1[1]); w.w = pk2(v1[2], v1[3]);
                        *(u32x4*)(Z + row * DM + col) = w;
                    } else { const int c2 = col - 4096;
                        if (c2 < PSW) { u32x4 w; w.x = pk2(v0[0], v0[1]); w.y = pk2(v0[2], v0[3]); w.z = pk2(v1[0], v1[1]); w.w = pk2(v1[2], v1[3]);
                            *(u32x4*)(PS + row * PSW + c2) = w; } } } }
    }
};
__device__ __forceinline__ unsigned pkh2(float a, float b) { const _Float16 ha = (_Float16)a, hb = (_Float16)b; return (unsigned)__builtin_bit_cast(unsigned short, ha) | ((unsigned)__builtin_bit_cast(unsigned short, hb) << 16); }
__device__ __forceinline__ float decay_rate(float val) {
    const float xx = -val; const float sp = fmaxf(xx, 0.f) + __logf(1.0f + __expf(-fabsf(xx))); return __expf(-sp - 0.5f);
}
__device__ __forceinline__ float sigmoidf_(float v) { return __builtin_amdgcn_rcpf(1.0f + __expf(-v)); }
struct EpiF16 {
    static constexpr bool PERM = true, AFTER_DRAIN = false;
    unsigned short* O; const float* w0; const float* a0;
    __device__ __forceinline__ void operator()(const f32x4 (&acc)[2][2][4][2], const pg8::Unit& u, int wr, int wc, int fr, int fq) const {
        const int row0 = u.pm * 256 + wr * 64 + fr, colt = u.pn * 256 + wc * 32 + 8 * fq;
        const int kind = u.pn >> 3;
        const float* bias = kind == 0 ? w0 : a0; const float scale = kind == 0 ? 0.6065306597126334f : 1.0f;
#pragma unroll
        for (int bj = 0; bj < 2; ++bj) { const int col = colt + bj * 128; f32x4 b0 = {0.f, 0.f, 0.f, 0.f}, b1 = b0;
            if (kind < 2) { b0 = *(const f32x4*)(bias + (col & 2047)); b1 = *(const f32x4*)(bias + (col & 2047) + 4); }
#pragma unroll
            for (int ai = 0; ai < 2; ++ai)
#pragma unroll
                for (int m = 0; m < 4; ++m) { const size_t row = (size_t)(row0 + ai * 128 + m * 16); f32x4 v0 = acc[ai][bj][m][0], v1 = acc[ai][bj][m][1];
                    if (kind < 2) {
#pragma unroll
                        for (int j = 0; j < 4; ++j) { v0[j] = scale * sigmoidf_(v0[j] + b0[j]); v1[j] = scale * sigmoidf_(v1[j] + b1[j]); } }
                    u32x4 w; w.x = pkh2(v0[0], v0[1]); w.y = pkh2(v0[2], v0[3]); w.z = pkh2(v1[0], v1[1]); w.w = pkh2(v1[2], v1[3]);
                    *(u32x4*)(O + row * LN_ + col) = w; asm volatile("" ::: "memory"); } }
    }
};
struct EpiNormPart {
    static constexpr bool PERM = true, AFTER_DRAIN = false;
    bf16_t* O; float* part;
    __device__ __forceinline__ void operator()(const f32x4 (&acc)[2][2][4][2], const pg8::Unit& u, int wr, int wc, int fr, int fq) const {
        const int row0 = u.pm * 256 + wr * 64 + fr, colt = u.pn * 256 + wc * 32 + 8 * fq;
#pragma unroll
        for (int ai = 0; ai < 2; ++ai)
#pragma unroll
            for (int m = 0; m < 4; ++m) { const size_t row = (size_t)(row0 + ai * 128 + m * 16); float s = 0.f;
#pragma unroll
                for (int bj = 0; bj < 2; ++bj) { const f32x4 v0 = acc[ai][bj][m][0], v1 = acc[ai][bj][m][1];
                    s += (v0[0] * v0[0] + v0[1] * v0[1]) + (v0[2] * v0[2] + v0[3] * v0[3]) + (v1[0] * v1[0] + v1[1] * v1[1]) + (v1[2] * v1[2] + v1[3] * v1[3]);
                    u32x4 w; w.x = pk2(v0[0], v0[1]); w.y = pk2(v0[2], v0[3]); w.z = pk2(v1[0], v1[1]); w.w = pk2(v1[2], v1[3]);
                    *(u32x4*)(O + row * DM + colt + bj * 128) = w; }
                s += __shfl_xor(s, 16); s += __shfl_xor(s, 32);
                if (fq == 0) part[row * 64 + u.pn * 4 + wc] = s; }
    }
};
struct EpiRelu2 {
    static constexpr bool PERM = true, AFTER_DRAIN = false;
    bf16_t* O;
    __device__ __forceinline__ void operator()(const f32x4 (&acc)[2][2][4][2], const pg8::Unit& u, int wr, int wc, int fr, int fq) const {
        const int row0 = u.pm * 256 + wr * 64 + fr, colt = u.pn * 256 + wc * 32 + 8 * fq;
#pragma unroll
        for (int ai = 0; ai < 2; ++ai)
#pragma unroll
            for (int m = 0; m < 4; ++m) { const size_t row = (size_t)(row0 + ai * 128 + m * 16);
#pragma unroll
                for (int bj = 0; bj < 2; ++bj) { f32x4 v0 = acc[ai][bj][m][0], v1 = acc[ai][bj][m][1];
#pragma unroll
                    for (int j = 0; j < 4; ++j) { const float a = fmaxf(v0[j], 0.f), b = fmaxf(v1[j], 0.f); v0[j] = a * a; v1[j] = b * b; }
                    u32x4 w; w.x = pk2(v0[0], v0[1]); w.y = pk2(v0[2], v0[3]); w.z = pk2(v1[0], v1[1]); w.w = pk2(v1[2], v1[3]);
                    *(u32x4*)(O + row * FFD + colt + bj * 128) = w; } }
    }
};

#define XB_TMO      128
#define XB_XCNT(j)  (256  + 64 * (j))
#define XB_XSUB(j)  (1280 + 64 * (j))
#define XB_XGEN(j)  (2304 + 64 * (j))
#define XB_TOP      3328
#define XB_TOPGEN   3392
#define XCD_BAR_WORDS 3456
#define XB_SPIN_CAP (1u << 18)
__device__ __forceinline__ unsigned xb_ld(unsigned* p)              { return __hip_atomic_load(p, __ATOMIC_RELAXED, __HIP_MEMORY_SCOPE_AGENT); }
__device__ __forceinline__ unsigned xb_add(unsigned* p, unsigned v) { return __hip_atomic_fetch_add(p, v, __ATOMIC_RELAXED, __HIP_MEMORY_SCOPE_AGENT); }
__device__ __forceinline__ unsigned xb_xcc_id() { return (unsigned)__builtin_amdgcn_s_getreg((3 << 11) | 20) & 0xFu; }
#define XB_SPIN(cond, bar) do { unsigned _sp = 0; while (cond) { __builtin_amdgcn_s_sleep(1); \
    if ((++_sp & 255u) == 0u) { if (xb_ld(&(bar)[XB_TMO])) break; if (_sp > XB_SPIN_CAP) { atomicAdd(&(bar)[XB_TMO], 1u); break; } } } } while (0)

struct XcdBarrier {
    unsigned* bar; unsigned x;
    volatile LAS unsigned* st;
};

__device__ __forceinline__ XcdBarrier xcd_barrier_post(unsigned* bar, volatile LAS unsigned* st) {
    XcdBarrier b; b.bar = bar; b.x = xb_xcc_id(); b.st = st;
    if (threadIdx.x == 0) (void)xb_add(&bar[XB_XCNT(b.x)], 1u);
    return b;
}
__device__ __forceinline__ void xcd_barrier_complete(unsigned* bar, unsigned x, unsigned& nloc, unsigned& nx) {
    const unsigned G = gridDim.x * gridDim.y * gridDim.z;
    unsigned sum, cnt, mine, sp = 0u;
    for (;;) {
        sum = 0u; cnt = 0u; mine = 0u;
#pragma unroll
        for (unsigned j = 0; j < 16; ++j) { const unsigned c = xb_ld(&bar[XB_XCNT(j)]); sum += c; cnt += (c > 0u) ? 1u : 0u; mine = (j == x) ? c : mine; }
        if (sum == G) break;
        __builtin_amdgcn_s_sleep(1);
        if ((++sp & 255u) == 0u) { if (xb_ld(&bar[XB_TMO])) break; if (sp > XB_SPIN_CAP) { atomicAdd(&bar[XB_TMO], 1u); break; } }
    }
    nloc = mine > 0u ? mine : 1u; nx = cnt > 0u ? cnt : 1u;
}

__device__ __forceinline__ void xcd_barrier(const XcdBarrier& b) {
    asm volatile("s_waitcnt vmcnt(0)" ::: "memory");
    __syncthreads();
    if (threadIdx.x == 0) {
        unsigned* bar = b.bar;
        __builtin_amdgcn_s_waitcnt(0);
        unsigned nloc = b.st[0], nx = b.st[1];
        if (nloc == 0u) { xcd_barrier_complete(bar, b.x, nloc, nx); b.st[0] = nloc; b.st[1] = nx; }
        const unsigned old = xb_add(&bar[XB_XSUB(b.x)], 1u);
        const unsigned gen = old / nloc;
        if (old + 1u == (gen + 1u) * nloc) {
            __builtin_amdgcn_fence(__ATOMIC_RELEASE, "agent");
            asm volatile("s_waitcnt vmcnt(0)" ::: "memory");
            const unsigned og = xb_add(&bar[XB_TOP], 1u);
            const unsigned tg = og / nx;
            if (og + 1u == (tg + 1u) * nx) xb_add(&bar[XB_TOPGEN], 1u);
            else XB_SPIN(xb_ld(&bar[XB_TOPGEN]) == tg, bar);
            __builtin_amdgcn_fence(__ATOMIC_ACQUIRE, "agent");
            xb_add(&bar[XB_XGEN(b.x)], 1u);
            asm volatile("s_waitcnt vmcnt(0)" ::: "memory");
        } else {
            XB_SPIN(xb_ld(&bar[XB_XGEN(b.x)]) == gen, bar);
            __builtin_amdgcn_fence(__ATOMIC_ACQUIRE, "agent");
            asm volatile("s_waitcnt vmcnt(0)" ::: "memory");
        }
    }
    __syncthreads();
}


typedef const __attribute__((address_space(4))) Params* KP;
__device__ __forceinline__ KP kparams() { unsigned long long q = (unsigned long long)__builtin_amdgcn_kernarg_segment_ptr(); asm volatile("" : "+s"(q) :: "memory"); return (KP)q; }
__device__ __forceinline__ void transpose_item(const float* W, int K, int N, bf16_t* WT, LAS float* scr, int item, int lane) {
    const int nblk = N / 32, kb = item / nblk, nb = item % nblk, k0 = 64 * kb, n0 = 32 * nb;
#pragma unroll 8
    for (int i = 0; i < 32; ++i) { const int kk = 2 * i + (lane >> 5); scr[kk * 33 + (lane & 31)] = W[(size_t)(k0 + kk) * N + n0 + (lane & 31)]; }
    LDS_WAIT();
    const int c = lane & 7;
#pragma unroll
    for (int j = 0; j < 4; ++j) { const int n = (lane >> 3) + 8 * j; const LAS float* s = scr + (8 * c) * 33 + n;
        u32x4 o; o.x = pk2(s[0 * 33], s[1 * 33]); o.y = pk2(s[2 * 33], s[3 * 33]); o.z = pk2(s[4 * 33], s[5 * 33]); o.w = pk2(s[6 * 33], s[7 * 33]);
        *(u32x4*)(WT + (size_t)(n0 + n) * K + k0 + 8 * c) = o; }
    LDS_WAIT();
}

__device__ __forceinline__ void phase0(KP p, unsigned char* lds, int gw, int NGW, int lane, int wave) {
    unsigned char* ws = p->wsb;
    LAS float* scr = (LAS float*)((LAS unsigned char*)lds + wave * 8448);
    bf16_t* WinT = (bf16_t*)(ws + OFF_WIN); bf16_t* WoT = (bf16_t*)(ws + OFF_WOT); bf16_t* W1T = (bf16_t*)(ws + OFF_W1T); bf16_t* W2T = (bf16_t*)(ws + OFF_W2T);
    constexpr int I_IN = (DM / 64) * (NPROJ / 32), I_O = (DM / 64) * (DM / 32), I_1 = (DM / 64) * (FFD / 32), I_2 = (FFD / 64) * (DM / 32);
    constexpr int NITEMS = I_IN;
    for (int it = gw; it < NITEMS; it += NGW) {
        int r = it;
        transpose_item(p->w_in, DM, NPROJ, WinT, scr, r, lane);
    }
    { u32x4* z = (u32x4*)(WinT + (size_t)NPROJ * DM); const size_t n16 = (size_t)(NPAD - NPROJ) * DM * 2 / 16; const u32x4 zero = {0u, 0u, 0u, 0u};
      for (size_t i = (size_t)gw * 64 + lane; i < n16; i += (size_t)NGW * 64) z[i] = zero; }
    { bf16_t* BT2 = (bf16_t*)(ws + OFF_BT2);
      for (size_t i = (size_t)gw * 64 + lane; i < (size_t)LN_ * LK; i += (size_t)NGW * 64) { const int n = (int)(i / LK), k = (int)(i % LK); float v = 0.f;
          if (n < 2048) { if (k < 64) v = p->w_up[(size_t)k * RW + n]; }
          else if (n < 4096) { if (k >= 64 && k < 128) v = p->a_up[(size_t)(k - 64) * RW + (n - 2048)]; }
          else { if (k >= 128) v = p->g_up[(size_t)(k - 128) * RW + (n - 4096)]; }
          BT2[i] = f2bf(v); } }
    bf16_t* H = (bf16_t*)(ws + OFF_H);
    for (int row = gw; row < M_TOK; row += NGW) {
        const float* gp0 = p->pre_mix_g; asm volatile("" : "+s"(gp0));
        const f32x4* xr = (const f32x4*)(p->x + (size_t)row * DM) + lane; f32x4 v[16]; float s = 0.f;
#pragma unroll
        for (int j = 0; j < 16; ++j) { v[j] = xr[64 * j]; s += (v[j].x * v[j].x + v[j].y * v[j].y) + (v[j].z * v[j].z + v[j].w * v[j].w); }
        const float rs = rsqrtf(wave_sum(s) * (1.0f / DM) + 1e-6f);
        u32x2* o = (u32x2*)(H + (size_t)row * DM) + lane;
#pragma unroll
        for (int j = 0; j < 16; ++j) { const f32x4 g = ((const f32x4*)gp0)[lane + 64 * j]; u32x2 w; w.x = pk2(v[j].x * rs * g.x, v[j].y * rs * g.y); w.y = pk2(v[j].z * rs * g.z, v[j].w * rs * g.w); o[64 * j] = w; }
    }
}

__device__ __forceinline__ void phase2(KP p, int gw, int NGW, int lane) {
    unsigned char* ws = p->wsb;
    const bf16_t* Z = (const bf16_t*)(ws + OFF_Z); const bf16_t* PS = (const bf16_t*)(ws + OFF_PS); bf16_t* A2 = (bf16_t*)(ws + OFF_A2); float* ST = (float*)(ws + OFF_ST);
    for (int row = gw; row < M_TOK; row += NGW) {
        const u32x4* zr = (const u32x4*)(Z + (size_t)row * DM + 2048) + lane; float v[32]; float s = 0.f;
#pragma unroll
        for (int j = 0; j < 4; ++j) { const u32x4 q = zr[64 * j];
            v[8 * j + 0] = bflo(q.x); v[8 * j + 1] = bfhi(q.x); v[8 * j + 2] = bflo(q.y); v[8 * j + 3] = bfhi(q.y); v[8 * j + 4] = bflo(q.z); v[8 * j + 5] = bfhi(q.z); v[8 * j + 6] = bflo(q.w); v[8 * j + 7] = bfhi(q.w); }
#pragma unroll
        for (int j = 0; j < 32; ++j) s += v[j];
        const float mean = wave_sum(s) * (1.0f / 2048.0f); float s2 = 0.f;
#pragma unroll
        for (int j = 0; j < 32; ++j) { const float d = v[j] - mean; s2 += d * d; }
        const float rstd = rsqrtf(wave_sum(s2) * (1.0f / 2048.0f) + 1e-5f);
        if (lane == 0) { ST[2 * row] = mean; ST[2 * row + 1] = rstd; }
        const bool has_prev = (row % T_SEQ) != 0;
#pragma unroll
        for (int i = 0; i < 6; ++i) { const int c = lane + 64 * i; const float cur = bf1(PS[(size_t)row * PSW + 6144 + c]);
            const float prev = has_prev ? bf1(PS[(size_t)(row - 1) * PSW + 6144 + c]) : 0.f; const float m = p->mu[6144 + c];
            float val = cur + (prev - cur) * m;
            if (i == 0) val = 1.0f - 2.0f * __builtin_amdgcn_rcpf(1.0f + __expf(2.0f * val));
            else if (i >= 2) val = sigmoidf_(val);
            A2[(size_t)row * LK + c] = f2bf(val); }
    }
}

__device__ __forceinline__ void phase_gmlp(KP p, unsigned char* ldsg, int tid, int lane, int wave) {
    unsigned char* ws = p->wsb;
    const bf16_t* Z = (const bf16_t*)(ws + OFF_Z); const float* ST = (const float*)(ws + OFF_ST); bf16_t* Y = (bf16_t*)(ws + OFF_Y);
    LAS bf16_t* Wm = (LAS bf16_t*)(LAS unsigned char*)ldsg; LAS bf16_t* Vt = Wm + 128 * 136;
    const int fr = lane & 15, fq = lane >> 4;
    const int si = tid >> 2, sb = (tid & 3) * 32;
    f32x4 wreg[8], greg[8], breg[8]; u32x4 zreg[4]; float mean = 0.f, rstd = 0.f;
#define GM_LOAD(UNIT) do { const int h_ = (UNIT) & 15, tok_ = ((UNIT) >> 4) * 128 + si; \
        const f32x4* wsrc_ = (const f32x4*)(p->ws + ((size_t)h_ * 128 + si) * 128 + sb); const u32x4* zsrc_ = (const u32x4*)(Z + (size_t)tok_ * DM + 2048 + h_ * 128 + sb); \
        const f32x4* gsrc_ = (const f32x4*)(p->ln_g + h_ * 128 + sb); const f32x4* bsrc_ = (const f32x4*)(p->ln_b + h_ * 128 + sb); \
        _Pragma("unroll") for (int q_ = 0; q_ < 8; ++q_) { wreg[q_] = wsrc_[q_]; greg[q_] = gsrc_[q_]; breg[q_] = bsrc_[q_]; } \
        _Pragma("unroll") for (int q_ = 0; q_ < 4; ++q_) zreg[q_] = zsrc_[q_]; \
        mean = ST[2 * tok_]; rstd = ST[2 * tok_ + 1]; } while (0)
    int unit = blockIdx.x;
    if (unit < 2048) GM_LOAD(unit);
    for (; unit < 2048; unit += gridDim.x) {
        const int h = unit & 15, bn = unit >> 4, tok0 = bn * 128;
        { const bool keep = (sb >> 6) <= (si >> 6);
#pragma unroll
          for (int q = 0; q < 4; ++q) { f32x4 a = wreg[2 * q], b = wreg[2 * q + 1]; if (!keep) { a = (f32x4){0.f, 0.f, 0.f, 0.f}; b = a; }
              u32x4 o; o.x = pk2(a.x, a.y); o.y = pk2(a.z, a.w); o.z = pk2(b.x, b.y); o.w = pk2(b.z, b.w); *(LAS u32x4*)(Wm + si * 136 + sb + 8 * q) = o; } }
        {
#pragma unroll
          for (int q = 0; q < 4; ++q) { const u32x4 z8 = zreg[q]; const float zf[8] = {bflo(z8.x), bfhi(z8.x), bflo(z8.y), bfhi(z8.y), bflo(z8.z), bfhi(z8.z), bflo(z8.w), bfhi(z8.w)};
              const f32x4 g0 = greg[2 * q], g1 = greg[2 * q + 1], b0 = breg[2 * q], b1 = breg[2 * q + 1];
#pragma unroll
              for (int e = 0; e < 8; ++e) { const float gg = e < 4 ? g0[e & 3] : g1[e & 3], bb = e < 4 ? b0[e & 3] : b1[e & 3];
                  Vt[(sb + 8 * q + e) * 136 + si] = f2bf((zf[e] - mean) * rstd * gg + bb); } } }
        __syncthreads();
        const int nxt = unit + gridDim.x;
        if (nxt < 2048) GM_LOAD(nxt);
        const int i0 = 16 * wave; const int tok = tok0 + i0 + fr; const float bias = p->bs[h * 128 + i0 + fr];
        u32x2 ureg[8];
#pragma unroll
        for (int ct = 0; ct < 8; ++ct) ureg[ct] = *(const u32x2*)(Z + (size_t)tok * DM + h * 128 + ct * 16 + 4 * fq);
        f32x4 acc[8];
#pragma unroll
        for (int ct = 0; ct < 8; ++ct) acc[ct] = (f32x4){0.f, 0.f, 0.f, 0.f};
        const int nks = (wave < 4) ? 2 : 4;
        for (int ks = 0; ks < nks; ++ks) { const bf16x8 wf = *(const LAS bf16x8*)(Wm + (i0 + fr) * 136 + ks * 32 + fq * 8);
#pragma unroll
            for (int ct = 0; ct < 8; ++ct) { const bf16x8 vf = *(const LAS bf16x8*)(Vt + (ct * 16 + fr) * 136 + ks * 32 + fq * 8);
                acc[ct] = __builtin_amdgcn_mfma_f32_16x16x32_bf16(vf, wf, acc[ct], 0, 0, 0); } }
#pragma unroll
        for (int ct = 0; ct < 8; ++ct) { const int c = h * 128 + ct * 16 + 4 * fq; const u32x2 uu = ureg[ct];
            u32x2 o; o.x = pk2(bflo(uu.x) * (acc[ct][0] + bias), bfhi(uu.x) * (acc[ct][1] + bias)); o.y = pk2(bflo(uu.y) * (acc[ct][2] + bias), bfhi(uu.y) * (acc[ct][3] + bias));
            *(u32x2*)(Y + (size_t)tok * DM + c) = o; }
        __syncthreads();
    }
#undef GM_LOAD
}

constexpr int BG_O = (DM / 64) * (DM / 64), BG_1 = (DM / 64) * (FFD / 64), BG_2 = (FFD / 64) * (DM / 64), BG_ITEMS = BG_O + BG_1 + BG_2;
struct BgRegs { float v[16]; };
__device__ __forceinline__ void bg_locate(KP p, int item, const float*& W, bf16_t*& WT, int& K, int& N, int& k0, int& n0) {
    unsigned char* ws = p->wsb; int r = item;
    if (r < BG_O) { W = p->w_out; WT = (bf16_t*)(ws + OFF_WOT); K = DM; N = DM; }
    else { r -= BG_O; if (r < BG_1) { W = p->w_ff1; WT = (bf16_t*)(ws + OFF_W1T); K = DM; N = FFD; } else { r -= BG_1; W = p->w_ff2; WT = (bf16_t*)(ws + OFF_W2T); K = FFD; N = DM; } }
    const int lg = (N == DM) ? 6 : 8; k0 = (r >> lg) * 64; n0 = (r & ((1 << lg) - 1)) * 64;
}
__device__ __forceinline__ void bg_load(KP p, BgRegs& R, int item, int w4, int lane) {
    const float* W; bf16_t* WT; int K, N, k0, n0; bg_locate(p, item, W, WT, K, N, k0, n0);
    const __amdgpu_buffer_rsrc_t rs = __builtin_amdgcn_make_buffer_rsrc((void*)W, 0, 0x7fffffff, 0x00020000);
    const unsigned vo = (unsigned)lane * 4u, sbase = (unsigned)(((k0 + 16 * w4) * N + n0) * 4), rowb = (unsigned)N * 4u;
#pragma unroll
    for (int i = 0; i < 16; ++i) R.v[i] = __builtin_bit_cast(float, __builtin_amdgcn_raw_buffer_load_b32(rs, vo, sbase + (unsigned)i * rowb, 0));
}
__device__ __forceinline__ void bg_store(KP p, const BgRegs& R, int item, int w4, int lane) {
    const float* W; bf16_t* WT; int K, N, k0, n0; bg_locate(p, item, W, WT, K, N, k0, n0);
    u32x4 a, b; a.x = pk2(R.v[0], R.v[1]); a.y = pk2(R.v[2], R.v[3]); a.z = pk2(R.v[4], R.v[5]); a.w = pk2(R.v[6], R.v[7]);
    b.x = pk2(R.v[8], R.v[9]); b.y = pk2(R.v[10], R.v[11]); b.z = pk2(R.v[12], R.v[13]); b.w = pk2(R.v[14], R.v[15]);
    u32x4* dst = (u32x4*)(WT + (size_t)(n0 + lane) * K + k0 + 16 * w4); dst[0] = a; dst[1] = b;
}
constexpr int SC = 32;
constexpr int SBUF = 43008, L_WW = 8192, L_BB = 16384, L_KP = 24576, L_RR = 32768, L_VV = 40960, L_YP = 2 * SBUF, YPB = 32768;
static_assert(L_YP + 2 * YPB <= LDS_BYTES, "scan LDS");
struct ScanConst { float mur[8], muk[8], muv[8], kk_[8], ka[8], w0[8], a0[8]; };
typedef _Float16 h8v __attribute__((ext_vector_type(8)));
struct ScanRaw { u32x4 rc, kc, vc, rp, kp_, vp; h8v e8, a8; };
__device__ __forceinline__ void scan_load(ScanRaw& R, const bf16_t* PS, const _Float16* LO, size_t tok, bool hasp, int hc) {
    const bf16_t* row = PS + tok * PSW + hc; const bf16_t* prow = row - PSW;
    const u32x4 zero = {0u, 0u, 0u, 0u};
    R.rc = *(const u32x4*)(row); R.kc = *(const u32x4*)(row + 2048); R.vc = *(const u32x4*)(row + 4096);
    R.rp = hasp ? *(const u32x4*)(prow) : zero; R.kp_ = hasp ? *(const u32x4*)(prow + 2048) : zero; R.vp = hasp ? *(const u32x4*)(prow + 4096) : zero;
    R.e8 = *(const h8v*)(LO + tok * LN_ + hc); R.a8 = *(const h8v*)(LO + tok * LN_ + 2048 + hc);
}
typedef __amdgpu_buffer_rsrc_t bufrsrc_t;
__device__ __forceinline__ bufrsrc_t make_rsrc(const void* p) { return __builtin_amdgcn_make_buffer_rsrc((void*)p, 0, 0x7fffffff, 0x00020000); }
struct ScanOff { unsigned r, k, v, e, a; };
__device__ __forceinline__ void scan_load_buf(ScanRaw& R, bufrsrc_t rsP, bufrsrc_t rsL, const ScanOff& o, unsigned soffP, unsigned soffL) {
    R.rc = __builtin_amdgcn_raw_buffer_load_b128(rsP, o.r, soffP, 0); R.kc = __builtin_amdgcn_raw_buffer_load_b128(rsP, o.k, soffP, 0); R.vc = __builtin_amdgcn_raw_buffer_load_b128(rsP, o.v, soffP, 0);
    const unsigned soffPp = soffP - (unsigned)(PSW * 2);
    R.rp = __builtin_amdgcn_raw_buffer_load_b128(rsP, o.r, soffPp, 0); R.kp_ = __builtin_amdgcn_raw_buffer_load_b128(rsP, o.k, soffPp, 0); R.vp = __builtin_amdgcn_raw_buffer_load_b128(rsP, o.v, soffPp, 0);
    R.e8 = __builtin_bit_cast(h8v, __builtin_amdgcn_raw_buffer_load_b128(rsL, o.e, soffL, 0)); R.a8 = __builtin_bit_cast(h8v, __builtin_amdgcn_raw_buffer_load_b128(rsL, o.a, soffL, 0));
}
__device__ __forceinline__ void scan_prep(LAS unsigned char* buf, const ScanConst& C, const ScanRaw& R, int pt, int kb, int q) {
    const u32x4 rc = R.rc, kc = R.kc, vc = R.vc, rp = R.rp, kp_ = R.kp_, vp = R.vp; const h8v e8 = R.e8, a8 = R.a8;
    float r[8], k[8], v[8], a[8], kk[8], wv[8], kq[8]; float ss = 0.f;
    const unsigned rcw[4] = {rc.x, rc.y, rc.z, rc.w}, rpw[4] = {rp.x, rp.y, rp.z, rp.w}, kcw[4] = {kc.x, kc.y, kc.z, kc.w}, kpw[4] = {kp_.x, kp_.y, kp_.z, kp_.w};
    const unsigned vcw[4] = {vc.x, vc.y, vc.z, vc.w}, vpw[4] = {vp.x, vp.y, vp.z, vp.w};
#pragma unroll
    for (int e = 0; e < 8; ++e) { const int wq = e >> 1; const bool hi = e & 1;
        const float rcf = hi ? bfhi(rcw[wq]) : bflo(rcw[wq]), rpf = hi ? bfhi(rpw[wq]) : bflo(rpw[wq]);
        const float kcf = hi ? bfhi(kcw[wq]) : bflo(kcw[wq]), kpf = hi ? bfhi(kpw[wq]) : bflo(kpw[wq]);
        const float vcf = hi ? bfhi(vcw[wq]) : bflo(vcw[wq]), vpf = hi ? bfhi(vpw[wq]) : bflo(vpw[wq]);
        r[e] = rcf + (rpf - rcf) * C.mur[e]; k[e] = kcf + (kpf - kcf) * C.muk[e]; v[e] = vcf + (vpf - vcf) * C.muv[e];
        a[e] = (float)a8[e];
        wv[e] = __expf(-(float)e8[e]);
        kk[e] = k[e] * C.kk_[e]; ss += kk[e] * kk[e];
        kq[e] = k[e] * (1.0f + (a[e] - 1.0f) * C.ka[e]); }
    ss += dpp_mov<0xB1>(ss); ss += dpp_mov<0x4E>(ss); ss += dpp_mov<0x141>(ss);
    const float inv = __builtin_amdgcn_rsqf(fmaxf(ss, 1e-24f));
#pragma unroll
    for (int e = 0; e < 8; ++e) kk[e] *= inv;
    LAS f32x4* d = (LAS f32x4*)(buf + pt * 256 + kb * 4);
    d[0] = (f32x4){kk[0], kk[1], kk[2], kk[3]}; d[1] = (f32x4){kk[4], kk[5], kk[6], kk[7]};
    d[L_WW / 16] = (f32x4){wv[0], wv[1], wv[2], wv[3]}; d[L_WW / 16 + 1] = (f32x4){wv[4], wv[5], wv[6], wv[7]};
    d[L_BB / 16] = (f32x4){kk[0] * a[0], kk[1] * a[1], kk[2] * a[2], kk[3] * a[3]}; d[L_BB / 16 + 1] = (f32x4){kk[4] * a[4], kk[5] * a[5], kk[6] * a[6], kk[7] * a[7]};
    d[L_KP / 16] = (f32x4){kq[0], kq[1], kq[2], kq[3]}; d[L_KP / 16 + 1] = (f32x4){kq[4], kq[5], kq[6], kq[7]};
    d[L_RR / 16] = (f32x4){r[0], r[1], r[2], r[3]}; d[L_RR / 16 + 1] = (f32x4){r[4], r[5], r[6], r[7]};
    if ((kb >> 4) == q) { LAS float* dv = (LAS float*)(buf + L_VV) + (kb & 15) * SC + pt;
#pragma unroll
        for (int e = 0; e < 8; ++e) dv[e * SC] = v[e]; }
}
__device__ __forceinline__ void scan_yreduce(const LAS unsigned char* ypb, float* YR, size_t tokbase, int colbase, int tid2) {
#pragma unroll
    for (int i = 0; i < 2; ++i) { const int o = tid2 + 256 * i, t = o >> 4, rw = o & 15;
        const LAS f32x4* s4 = (const LAS f32x4*)(ypb + (size_t)o * 64);
        const f32x4 a = s4[0], b = s4[1], c = s4[2], d = s4[3];
        const f32x4 z = (a + b) + (c + d);
        YR[(tokbase + t) * RW + colbase + rw] = (z.x + z.y) + (z.z + z.w); }
}
__device__ __forceinline__ void scan_consume(f32x4& S, const LAS unsigned char* buf, LAS unsigned char* ypb, int j, int rl, int wave, int lane) {
    const LAS f32x4* base = (const LAS f32x4*)(buf) + j;
    const LAS f32x4* vb4 = (const LAS f32x4*)(buf + L_VV) + rl * (SC / 4);
    LAS float* yp = (LAS float*)(ypb) + wave * 64 + lane;
    f32x4 kkq[3], wq[3], bq[3], kq[3], rq[3]; f32x4 vq4[2];
#pragma unroll
    for (int u = 0; u < 2; ++u) { kkq[u] = base[u * 16]; wq[u] = base[L_WW / 16 + u * 16]; bq[u] = base[L_BB / 16 + u * 16]; kq[u] = base[L_KP / 16 + u * 16]; rq[u] = base[L_RR / 16 + u * 16]; }
    vq4[0] = vb4[0];
#pragma unroll
    for (int t = 0; t < SC; ++t) {
        const int tn = (t + 2 < SC) ? t + 2 : SC - 1; const int sl = (t + 2) % 3, cu = t % 3;
        kkq[sl] = base[tn * 16]; wq[sl] = base[L_WW / 16 + tn * 16]; bq[sl] = base[L_BB / 16 + tn * 16]; kq[sl] = base[L_KP / 16 + tn * 16]; rq[sl] = base[L_RR / 16 + tn * 16];
        if ((t & 3) == 0 && t + 4 < SC) vq4[((t >> 2) + 1) & 1] = vb4[(t >> 2) + 1];
        const f32x4 kk4 = kkq[cu], w4 = wq[cu], b4 = bq[cu], k4 = kq[cu], r4 = rq[cu]; const float vv = vq4[(t >> 2) & 1][t & 3];
        float sa = fmaf(S.w, kk4.w, fmaf(S.z, kk4.z, fmaf(S.y, kk4.y, S.x * kk4.x)));
        const f32x4 vk = vv * k4;
        sa = -red16(sa);
        S = S * w4 + (sa * b4 + vk);
        yp[t * 256] = fmaf(S.w, r4.w, fmaf(S.z, r4.z, fmaf(S.y, r4.y, S.x * r4.x)));
    }
}
#define SCAN_BAR() do { asm volatile("s_waitcnt lgkmcnt(0)" ::: "memory"); __builtin_amdgcn_s_barrier(); asm volatile("" ::: "memory"); } while (0)
__device__ __forceinline__ void phase_scan(KP p, unsigned char* ldsg, int tid, int lane, int wave) {
    unsigned char* ws = p->wsb;
    const bf16_t* PS = (const bf16_t*)(ws + OFF_PS); const _Float16* LO = (const _Float16*)(ws + OFF_LO); float* YR = (float*)(ws + OFF_YRAW);
    LAS unsigned char* lds = (LAS unsigned char*)ldsg;
    const int G = gridDim.x, bx = blockIdx.x; const int vcu = (G % 8 == 0) ? (bx % 8) * (G / 8) + bx / 8 : bx;
    constexpr int NCH = T_SEQ / SC;
    int iter = 0;
    for (int su = vcu; su < 256; su += G, ++iter) {
        const int hp = su >> 2, q = su & 3, b = hp >> 5, h = hp & 31;
        const size_t tokb = (size_t)b * T_SEQ; const int colbase = h * 64 + q * 16;
#ifdef PROBE_ISO
        { f32x4 Sp = {0.f, 0.f, 0.f, 0.f};
          if (wave < 4) { for (int c = 0; c < PROBE_ISO; ++c) { scan_consume(Sp, lds, lds + L_YP, lane & 15, wave * 4 + (lane >> 4), wave, lane); asm volatile("" ::: "memory"); }
              if (Sp.x == 1.2345e-30f) YR[0] = Sp.y; }
          __syncthreads(); }
#endif
        if (wave >= 4) {
            const int tid2 = tid - 256, pt = tid2 >> 3, kb = (tid2 & 7) * 8, hc = h * 64 + kb;
            ScanConst C;
#pragma unroll
            for (int e = 0; e < 8; ++e) { C.mur[e] = p->mu[hc + e]; C.muk[e] = p->mu[2048 + hc + e]; C.muv[e] = p->mu[4096 + hc + e]; C.kk_[e] = p->k_k[hc + e]; C.ka[e] = p->k_a[hc + e]; C.w0[e] = p->w0[hc + e]; C.a0[e] = p->a0[hc + e]; }
            ScanRaw A, B;
            ScanOff so; so.r = (unsigned)(pt * PSW + hc) * 2u; so.k = so.r + 4096u; so.v = so.r + 8192u; so.e = (unsigned)(pt * LN_ + hc) * 2u; so.a = so.e + 4096u;
            const bufrsrc_t rsP = make_rsrc(PS), rsL = make_rsrc(LO);
            const unsigned pbase = (unsigned)(tokb * PSW * 2), lbase = (unsigned)(tokb * LN_ * 2);
            scan_load(A, PS, LO, tokb + pt, pt > 0, hc);
            scan_prep(lds, C, A, pt, kb, q);
            scan_load(A, PS, LO, tokb + SC + pt, true, hc);
            const int w4 = wave - 4; BgRegs BG; int bg_cur = -1;
            int bg_next = (iter * NCH) * G + bx;
            SCAN_BAR();
#define SCAN_PRODUCE(CUR, NXT, c) do { \
                if ((c) + 2 < NCH) scan_load_buf(NXT, rsP, rsL, so, pbase + (unsigned)((c) + 2) * (unsigned)(SC * PSW * 2), lbase + (unsigned)((c) + 2) * (unsigned)(SC * LN_ * 2));     \
                if ((c) + 1 < NCH) scan_prep(lds + (((c) + 1) & 1) * SBUF, C, CUR, pt, kb, q); \
                if ((c) >= 1) scan_yreduce(lds + L_YP + (((c) - 1) & 1) * YPB, YR, tokb + (size_t)((c) - 1) * SC, colbase, tid2); \
                if (bg_cur >= 0) { bg_store(p, BG, bg_cur, w4, lane); bg_cur = -1; } \
                if (bg_next < BG_ITEMS) { bg_load(p, BG, bg_next, w4, lane); bg_cur = bg_next; } \
                bg_next += G; \
                SCAN_BAR(); } while (0)
            for (int c = 0; c < NCH; c += 2) { SCAN_PRODUCE(A, B, c); SCAN_PRODUCE(B, A, c + 1); }
#undef SCAN_PRODUCE
            if (bg_cur >= 0) bg_store(p, BG, bg_cur, w4, lane);
            scan_yreduce(lds + L_YP + ((NCH - 1) & 1) * YPB, YR, tokb + (size_t)(NCH - 1) * SC, colbase, tid2);
        } else {
            const int j = lane & 15, rl = wave * 4 + (lane >> 4);
            f32x4 S = {0.f, 0.f, 0.f, 0.f};
            __builtin_amdgcn_s_setprio(3);
            SCAN_BAR();
            for (int c = 0; c < NCH; ++c) {
                scan_consume(S, lds + (c & 1) * SBUF, lds + L_YP + (c & 1) * YPB, j, rl, wave, lane);
                SCAN_BAR();
            }
            __builtin_amdgcn_s_setprio(0);
        }
        __syncthreads();
    }
    if (wave >= 4) { BgRegs BG; for (int item = (iter * NCH) * G + bx; item < BG_ITEMS; item += G) { bg_load(p, BG, item, wave - 4, lane); bg_store(p, BG, item, wave - 4, lane); } }
}

__device__ __forceinline__ void phase_post(KP p, int gw, int NGW, int lane) {
    unsigned char* ws = p->wsb;
    const bf16_t* PS = (const bf16_t*)(ws + OFF_PS); const _Float16* LO = (const _Float16*)(ws + OFF_LO); const float* YR = (const float*)(ws + OFF_YRAW); bf16_t* Y = (bf16_t*)(ws + OFF_Y);
    for (int tok = gw; tok < M_TOK; tok += NGW) {
        const bool hasp = (tok % T_SEQ) != 0;
        const bf16_t* row = PS + (size_t)tok * PSW; const bf16_t* prow = row - PSW;
#pragma unroll 2
        for (int hg = 0; hg < 8; ++hg) { const int col = hg * 256 + lane * 4;
            const f32x4 y = *(const f32x4*)(YR + (size_t)tok * RW + col);
            const u32x2 z2 = {0u, 0u};
            const u32x2 rc = *(const u32x2*)(row + col), kc = *(const u32x2*)(row + 2048 + col), vc = *(const u32x2*)(row + 4096 + col);
            const u32x2 rp = hasp ? *(const u32x2*)(prow + col) : z2, kp = hasp ? *(const u32x2*)(prow + 2048 + col) : z2, vp = hasp ? *(const u32x2*)(prow + 4096 + col) : z2;
            const f32x4 mur = *(const f32x4*)(p->mu + col), muk = *(const f32x4*)(p->mu + 2048 + col), muv = *(const f32x4*)(p->mu + 4096 + col);
            typedef _Float16 h4 __attribute__((ext_vector_type(4))); const h4 a2 = *(const h4*)(LO + (size_t)tok * LN_ + 2048 + col), g2 = *(const h4*)(LO + (size_t)tok * LN_ + 4096 + col);
            const f32x4 ka = *(const f32x4*)(p->k_a + col), rk = *(const f32x4*)(p->r_k + col), lg = *(const f32x4*)(p->lnx_g + col), lb = *(const f32x4*)(p->lnx_b + col);
            const f32x4 rcf = {bflo(rc.x), bfhi(rc.x), bflo(rc.y), bfhi(rc.y)}, rpf = {bflo(rp.x), bfhi(rp.x), bflo(rp.y), bfhi(rp.y)};
            const f32x4 kcf = {bflo(kc.x), bfhi(kc.x), bflo(kc.y), bfhi(kc.y)}, kpf = {bflo(kp.x), bfhi(kp.x), bflo(kp.y), bfhi(kp.y)};
            const f32x4 vcf = {bflo(vc.x), bfhi(vc.x), bflo(vc.y), bfhi(vc.y)}, vpf = {bflo(vp.x), bfhi(vp.x), bflo(vp.y), bfhi(vp.y)};
            const f32x4 af = {(float)a2[0], (float)a2[1], (float)a2[2], (float)a2[3]}, gf = {(float)g2[0], (float)g2[1], (float)g2[2], (float)g2[3]};
            const f32x4 r = rcf + (rpf - rcf) * mur, k = kcf + (kpf - kcf) * muk, v = vcf + (vpf - vcf) * muv;
            const f32x4 kq = k * (1.0f + (af - 1.0f) * ka);
            const f32x4 rkk = r * kq * rk;
            const float bonus = red16((rkk.x + rkk.y) + (rkk.z + rkk.w));
            const float mean = red16((y.x + y.y) + (y.z + y.w)) * (1.0f / 64.0f);
            const f32x4 d = y - mean;
            const float var = red16((d.x * d.x + d.y * d.y) + (d.z * d.z + d.w * d.w)) * (1.0f / 64.0f);
            const float rstd = rsqrtf(var + 64e-5f);
            const f32x4 o = ((d * rstd) * lg + lb + bonus * v) * gf;
            u32x2 w; w.x = pk2(o.x, o.y); w.y = pk2(o.z, o.w);
            *(u32x2*)(Y + (size_t)tok * DM + 2048 + col) = w; }
    }
}

__device__ __forceinline__ void phase7(KP p, int gw, int NGW, int lane) {
    unsigned char* ws = p->wsb;
    const bf16_t* MIX = (const bf16_t*)(ws + OFF_MIX); const float* SS = (const float*)(ws + OFF_SS1); bf16_t* H = (bf16_t*)(ws + OFF_H);
    for (int row = gw; row < M_TOK; row += NGW) {
        const float* gp1 = p->post_mix_g; const float* gp2 = p->pre_ffn_g; asm volatile("" : "+s"(gp1), "+s"(gp2));
        const float rs1 = rsqrtf(wave_sum(SS[(size_t)row * 64 + lane]) * (1.0f / DM) + 1e-6f);
        const f32x4* xr = (const f32x4*)(p->x + (size_t)row * DM) + lane; const u32x2* mr = (const u32x2*)(MIX + (size_t)row * DM) + lane;
        u32x2* x1row = (u32x2*)(p->out + (size_t)row * DM) + lane; u32x2* hrow = (u32x2*)(H + (size_t)row * DM) + lane;
        f32x4 v[16]; float s = 0.f;
#pragma unroll
        for (int jh = 0; jh < 4; ++jh) {
            const f32x4* xg = xr + 256 * jh; const u32x2* mg = mr + 256 * jh; const f32x4* gg1 = (const f32x4*)gp1 + lane + 256 * jh; asm volatile("" : "+v"(xg), "+v"(mg), "+v"(gg1));
#pragma unroll
            for (int jj = 0; jj < 4; ++jj) { const int j = jh * 4 + jj; const f32x4 xx = xg[64 * jj]; const u32x2 mm = mg[64 * jj]; const f32x4 g = gg1[64 * jj];
                const f32x4 mf = {bflo(mm.x), bfhi(mm.x), bflo(mm.y), bfhi(mm.y)};
                v[j] = xx + (mf * rs1) * g; s += (v[j].x * v[j].x + v[j].y * v[j].y) + (v[j].z * v[j].z + v[j].w * v[j].w); }
            asm volatile("" ::: "memory"); }
        const float rs2 = rsqrtf(wave_sum(s) * (1.0f / DM) + 1e-6f);
#pragma unroll
        for (int jh = 0; jh < 4; ++jh) {
            u32x2* x1g = x1row + 256 * jh; u32x2* hg = hrow + 256 * jh; const f32x4* gg2 = (const f32x4*)gp2 + lane + 256 * jh; asm volatile("" : "+v"(x1g), "+v"(hg), "+v"(gg2));
#pragma unroll
            for (int jj = 0; jj < 4; ++jj) { const int j = jh * 4 + jj; const f32x4 g = gg2[64 * jj];
                u32x2 w; w.x = pk2(v[j].x, v[j].y); w.y = pk2(v[j].z, v[j].w); x1g[64 * jj] = w;
                u32x2 h; h.x = pk2(v[j].x * rs2 * g.x, v[j].y * rs2 * g.y); h.y = pk2(v[j].z * rs2 * g.z, v[j].w * rs2 * g.w); hg[64 * jj] = h; }
            asm volatile("" ::: "memory"); }
    }
}
__device__ __forceinline__ void phase10(KP p, int gw, int NGW, int lane) {
    unsigned char* ws = p->wsb;
    const bf16_t* F = (const bf16_t*)(ws + OFF_F); const float* SS = (const float*)(ws + OFF_SS2);
    for (int row = gw; row < M_TOK; row += NGW) {
        const float* gp3 = p->post_ffn_g; asm volatile("" : "+s"(gp3));
        const float rs = rsqrtf(wave_sum(SS[(size_t)row * 64 + lane]) * (1.0f / DM) + 1e-6f);
        f32x4* orow = (f32x4*)(p->out + (size_t)row * DM) + lane; const u32x2* x1row = (const u32x2*)(p->out + (size_t)row * DM) + lane; const u32x2* fr_ = (const u32x2*)(F + (size_t)row * DM) + lane;
        u32x2 xb[16], fb[16];
#pragma unroll
        for (int j = 0; j < 16; ++j) { xb[j] = x1row[64 * j]; fb[j] = fr_[64 * j]; }
        asm volatile("s_waitcnt vmcnt(0)" ::: "memory");
#pragma unroll
        for (int j = 0; j < 16; ++j) { const f32x4 g = ((const f32x4*)gp3)[lane + 64 * j];
            const f32x4 xx = {bflo(xb[j].x), bfhi(xb[j].x), bflo(xb[j].y), bfhi(xb[j].y)}, mf = {bflo(fb[j].x), bfhi(fb[j].x), bflo(fb[j].y), bfhi(fb[j].y)};
            orow[64 * j] = xx + (mf * rs) * g; }
    }
}

constexpr int NPHASE = 11;
__global__ void __launch_bounds__(NTHREADS, 2) fwd_megakernel(Params p_) {
    extern __shared__ __attribute__((aligned(16))) unsigned char lds[];
    const int tid = threadIdx.x, lane = tid & 63, wave = __builtin_amdgcn_readfirstlane(tid >> 6);
    const int G = gridDim.x, gw = blockIdx.x * NWAVES + wave, NGW = G * NWAVES;
    const int lo = p_.ph_lo, hi = p_.ph_hi;
    volatile LAS unsigned* xst = (volatile LAS unsigned*)((LAS unsigned char*)lds + (LDS_BYTES - 16));
    XcdBarrier xbar; xbar.bar = nullptr; xbar.x = 0; xbar.st = xst;
    if (p_.coop) { if (tid == 0) { xst[0] = 0u; xst[1] = 0u; } __syncthreads(); xbar = xcd_barrier_post((unsigned*)(p_.wsb + OFF_BAR), xst); }
    if (p_.coop == 2) cg::this_grid().sync();
#define GRIDBAR() xcd_barrier(xbar)
#ifndef PH_MASK
#define PH_MASK 0x7ff
#endif
#define IN(k) ((((PH_MASK) >> (k)) & 1) && lo <= (k) && (k) < hi)
#define SEAM(k) do { if (IN(k) && IN((k) + 1)) { GRIDBAR(); } } while (0)
#ifndef REPEAT_MASK
#define REPEAT_MASK 0
#endif
#define REPS(k) ((((REPEAT_MASK) >> (k)) & 1) ? 2 : 1)
#define RSYNC(k, r) do { if ((r) + 1 < REPS(k)) GRIDBAR(); } while (0)
    if (IN(0)) { for (int rep = 0; rep < REPS(0); ++rep) { KP p = kparams(); phase0(p, lds, gw, NGW, lane, wave); RSYNC(0, rep); } } SEAM(0);
    if (IN(1)) for (int rep = 0; rep < REPS(1); ++rep) { KP p = kparams(); unsigned char* ws = p->wsb; pg8::Gemm g{(const bf16_t*)(ws + OFF_H), (const bf16_t*)(ws + OFF_WIN), M_TOK, NPAD, DM}; pg8::StaticOrder S; S.init(M_TOK, NPAD, G, (int)blockIdx.x);
        EpiProj E{(bf16_t*)(ws + OFF_Z), (bf16_t*)(ws + OFF_PS)};
        pg8::gemm_phase<EpiProj, pg8::StaticOrder>((PG8_LAS unsigned char*)lds, g, S, E, nullptr); RSYNC(1, rep); } SEAM(1);
    if (IN(2)) { for (int rep = 0; rep < REPS(2); ++rep) { KP p = kparams(); phase2(p, gw, NGW, lane); RSYNC(2, rep); } } SEAM(2);
    if (IN(3)) for (int rep = 0; rep < REPS(3); ++rep) { KP p = kparams(); unsigned char* ws = p->wsb; { pg8::Gemm g{(const bf16_t*)(ws + OFF_A2), (const bf16_t*)(ws + OFF_BT2), M_TOK, LN_, LK}; pg8::StaticOrder S; S.init(M_TOK, LN_, G, (int)blockIdx.x);
          EpiF16 E{(unsigned short*)(ws + OFF_LO), p->w0, p->a0};
          pg8::gemm_phase<EpiF16, pg8::StaticOrder>((PG8_LAS unsigned char*)lds, g, S, E, nullptr); }
        __syncthreads();
        phase_gmlp(p, lds, tid, lane, wave); RSYNC(3, rep); } SEAM(3);
    if (IN(4)) { for (int rep = 0; rep < REPS(4); ++rep) { KP p = kparams(); phase_scan(p, lds, tid, lane, wave); RSYNC(4, rep); } } SEAM(4);
    if (IN(5)) { for (int rep = 0; rep < REPS(5); ++rep) { KP p = kparams(); phase_post(p, gw, NGW, lane); RSYNC(5, rep); } } SEAM(5);
    if (IN(6)) for (int rep = 0; rep < REPS(6); ++rep) { KP p = kparams(); unsigned char* ws = p->wsb; pg8::Gemm g{(const bf16_t*)(ws + OFF_Y), (const bf16_t*)(ws + OFF_WOT), M_TOK, DM, DM}; pg8::StaticOrder S; S.init(M_TOK, DM, G, (int)blockIdx.x);
        EpiNormPart E{(bf16_t*)(ws + OFF_MIX), (float*)(ws + OFF_SS1)};
        pg8::gemm_phase<EpiNormPart, pg8::StaticOrder>((PG8_LAS unsigned char*)lds, g, S, E, nullptr); RSYNC(6, rep); } SEAM(6);
    if (IN(7)) { for (int rep = 0; rep < REPS(7); ++rep) { KP p = kparams(); phase7(p, gw, NGW, lane); RSYNC(7, rep); } } SEAM(7);
    if (IN(8)) for (int rep = 0; rep < REPS(8); ++rep) { KP p = kparams(); unsigned char* ws = p->wsb; pg8::Gemm g{(const bf16_t*)(ws + OFF_H), (const bf16_t*)(ws + OFF_W1T), M_TOK, FFD, DM}; pg8::StaticOrder S; S.init(M_TOK, FFD, G, (int)blockIdx.x);
        EpiRelu2 E{(bf16_t*)(ws + OFF_HID)};
        pg8::gemm_phase<EpiRelu2, pg8::StaticOrder>((PG8_LAS unsigned char*)lds, g, S, E, nullptr); RSYNC(8, rep); } SEAM(8);
    if (IN(9)) for (int rep = 0; rep < REPS(9); ++rep) { KP p = kparams(); unsigned char* ws = p->wsb; pg8::Gemm g{(const bf16_t*)(ws + OFF_HID), (const bf16_t*)(ws + OFF_W2T), M_TOK, DM, FFD}; pg8::StaticOrder S; S.init(M_TOK, DM, G, (int)blockIdx.x);
        EpiNormPart E{(bf16_t*)(ws + OFF_F), (float*)(ws + OFF_SS2)};
        pg8::gemm_phase<EpiNormPart, pg8::StaticOrder>((PG8_LAS unsigned char*)lds, g, S, E, nullptr); RSYNC(9, rep); } SEAM(9);
    if (IN(10)) { KP p = kparams(); phase10(p, gw, NGW, lane); }
#undef IN
#undef SEAM
}

#ifndef N_LAUNCH_MODE
#define N_LAUNCH_MODE 1
#endif
extern "C" void kernel_launch(void* const* d_in, const int* in_sizes, int n_in, void* d_out, int out_size, void* d_ws, size_t ws_size, hipStream_t stream) {
    static int grid = 0;
    if (grid == 0) {
        int dev = 0, cus = 0, per_cu = 0;
        (void)hipGetDevice(&dev); (void)hipDeviceGetAttribute(&cus, hipDeviceAttributeMultiprocessorCount, dev);
        if (hipFuncSetAttribute((const void*)fwd_megakernel, hipFuncAttributeMaxDynamicSharedMemorySize, LDS_BYTES) != hipSuccess) fprintf(stderr, "hipFuncSetAttribute failed\n");
        if (hipOccupancyMaxActiveBlocksPerMultiprocessor(&per_cu, (const void*)fwd_megakernel, NTHREADS, LDS_BYTES) != hipSuccess || per_cu < 1) { fprintf(stderr, "occupancy query: %d\n", per_cu); per_cu = 1; }
        (void)hipGetLastError();
        grid = cus * 1;
        if (n_in != 24 || ws_size < WS_END) fprintf(stderr, "unexpected n_in %d / ws_size %zu (need %zu)\n", n_in, ws_size, (size_t)WS_END);
    }
    Params p{};
    const float** pp = (const float**)&p;
    for (int i = 0; i < 24; ++i) pp[i] = (const float*)d_in[i];
    p.out = (float*)d_out; p.wsb = (unsigned char*)d_ws; p.pad = 0;
#if N_LAUNCH_MODE == 1
    p.ph_lo = 0; p.ph_hi = NPHASE; p.coop = 1;
    (void)hipMemsetAsync((unsigned char*)d_ws + OFF_BAR, 0, 16384, stream);
    void* args[] = {&p};
    hipError_t e = hipLaunchCooperativeKernel((const void*)fwd_megakernel, dim3(grid), dim3(NTHREADS), args, LDS_BYTES, stream);
    if (e != hipSuccess) fprintf(stderr, "cooperative launch failed: %s (grid %d)\n", hipGetErrorString(e), grid);
#else
    for (int ph = 0; ph < NPHASE; ++ph) { p.ph_lo = ph; p.ph_hi = ph + 1; p.coop = 0;
        hipLaunchKernelGGL(fwd_megakernel, dim3(grid), dim3(NTHREADS), LDS_BYTES, stream, p); }
#endif
}
```

```cpp
#include <hip/hip_runtime.h>
#include <hip/hip_cooperative_groups.h>
#include <cstdio>
namespace cg = cooperative_groups;
namespace pg8 {
#define PG8_LAS __attribute__((address_space(3)))
typedef unsigned short bf16_t;
typedef short bf16x8 __attribute__((ext_vector_type(8)));
typedef float f32x4 __attribute__((ext_vector_type(4)));
typedef unsigned u32x4 __attribute__((ext_vector_type(4)));
constexpr int BM = 256, BK = 64, HALF = 128, HTB = HALF * BK * 2  , STAGE_BYTES = 8 * HTB, NXCD = 8, WGM = 8;

__host__ __device__ __forceinline__ int lds_byte(int r, int c) { const int st = (r >> 4) * 2 + (c >> 5), rr = r & 15, cc = c & 31, ob = rr * 64 + cc * 2; return st * 1024 + (ob ^ (((ob >> 9) & 1) << 5)); }
__host__ __device__ __forceinline__ void stage_rc(int b, int& R, int& C) { const int st = b / 1024, sb = b % 1024, swz = sb ^ (((sb >> 9) & 1) << 5); R = (st >> 1) * 16 + swz / 64; C = (st & 1) * 32 + (swz % 64) / 2; }
__host__ __device__ __forceinline__ int perm32(int rho) { const int n = rho >> 4, i = rho & 15; return 8 * (i >> 2) + 4 * n + (i & 3); }

struct Unit { int pm, pn, ko; };
struct Gemm { const bf16_t* A; const bf16_t* Bt; int M, N, K, ld; };

struct StaticOrder {
    int nM, nN, nwg, G, c, ko;
    __host__ __device__ void init(int M, int N, int G_, int c_, int ko_ = 0) { nM = M / BM; nN = N / BM; nwg = nM * nN; G = G_; c = c_; ko = ko_; }
    __host__ __device__ bool next(int i, Unit& u) const {
        const long L = (long)i * G + c; if (L >= nwg) return false;
        int wgid = (int)L; { const int q = nwg / NXCD, r = nwg % NXCD, xcd = wgid % NXCD, off = wgid / NXCD; wgid = (xcd < r ? xcd * (q + 1) : r * (q + 1) + (xcd - r) * q) + off; }
        const int nig = WGM * nN, gid = wgid / nig, fm = gid * WGM, gsz = (nM - fm) < WGM ? (nM - fm) : WGM;
        u.pm = fm + ((wgid % nig) % gsz); u.pn = (wgid % nig) / gsz; u.ko = ko; return true;
    }
    __device__ __forceinline__ void a_ready(const Unit&) const {}
    __device__ __forceinline__ void done(const Unit&) const {}
};
__device__ __forceinline__ unsigned cvt_pk_bf16(float lo, float hi) { unsigned r; asm volatile("v_cvt_pk_bf16_f32 %0, %1, %2" : "=v"(r) : "v"(lo), "v"(hi)); return r; }
typedef float f32x2 __attribute__((ext_vector_type(2)));
template <class Epi, class Sched, bool STAMP = false>
__device__ __forceinline__ void gemm_phase(PG8_LAS unsigned char* lds, const Gemm g, const Sched& S, const Epi& E, unsigned long long* stamps) {
    const int tid = threadIdx.x, wid = __builtin_amdgcn_readfirstlane(tid >> 6), lane = tid & 63, wr = wid >> 2, wc = wid & 3, fr = lane & 15, fq = lane >> 4;
    const int K = g.K, nt = K / BK;
    int ts_lo = 0, ts_hi = 0, nts = 0; const unsigned long long rt_entry = STAMP ? (unsigned long long)wall_clock64() : 0ull;
#define PG8_STAMP() do { if (STAMP && wid == 0 && nts < 64) { const unsigned long long _c = (unsigned long long)clock64(); \
        ts_lo = (lane == nts) ? (int)(unsigned)_c : ts_lo; ts_hi = (lane == nts) ? (int)(unsigned)(_c >> 32) : ts_hi; ++nts; } } while (0)
    PG8_STAMP();
    unsigned voffA[2], voffB[2];
#pragma unroll
    for (int i = 0; i < 2; ++i) { int R, C; stage_rc(tid * 16 + i * 8192, R, C); const int Rb = Epi::PERM ? ((R & ~31) + perm32(R & 31)) : R;
        voffA[i] = (unsigned)(R * g.ld + C) * 2u; voffB[i] = (unsigned)(Rb * g.ld + C) * 2u; }
    const size_t kstep = (size_t)(BK * 2);
    const size_t hstep = (size_t)HALF * g.ld * 2;
    const size_t tstep = 2 * hstep;
    const unsigned ldsw = (unsigned)wid * 1024u;
    const int aoff = lds_byte(wr * 64 + fr, fq * 8), boff = lds_byte(wc * 32 + fr, fq * 8);
#define PG8_SA(b, h) (((b) * 2 + (h)) * HTB)
#define PG8_SB(b, h) ((4 + (b) * 2 + (h)) * HTB)
#define PG8_STAGE(bufoff, gbase, voff) do { _Pragma("unroll") for (int _i = 0; _i < 2; ++_i) \
        __builtin_amdgcn_global_load_lds((const unsigned*)((const char*)(gbase) + (voff)[_i]), (PG8_LAS unsigned*)(lds + (bufoff) + ldsw + _i * 8192), 16, 0, 0); } while (0)
#define PG8_LDA(dst, b, h) do { _Pragma("unroll") for (int m = 0; m < 4; ++m) _Pragma("unroll") for (int k = 0; k < 2; ++k) dst[m][k] = *(const PG8_LAS bf16x8*)(lds + PG8_SA(b, h) + aoff + m * 2048 + k * 1024); } while (0)
#define PG8_LDB(dst, b, h) do { _Pragma("unroll") for (int n = 0; n < 2; ++n) _Pragma("unroll") for (int k = 0; k < 2; ++k) dst[n][k] = *(const PG8_LAS bf16x8*)(lds + PG8_SB(b, h) + boff + n * 2048 + k * 1024); } while (0)
#define PG8_MMA(ai, bj, At, Bt) do { __builtin_amdgcn_s_setprio(1); _Pragma("unroll") for (int m = 0; m < 4; ++m) _Pragma("unroll") for (int n = 0; n < 2; ++n) _Pragma("unroll") for (int k = 0; k < 2; ++k) \
        acc[ai][bj][m][n] = __builtin_amdgcn_mfma_f32_16x16x32_bf16(Bt[n][k], At[m][k], acc[ai][bj][m][n], 0, 0, 0); __builtin_amdgcn_s_setprio(0); } while (0)
#define PG8_WAIT_V(n) asm volatile("s_waitcnt vmcnt(" #n ")" ::: "memory")
#define PG8_WAIT_L(n) asm volatile("s_waitcnt lgkmcnt(" #n ")" ::: "memory")
#define PG8_BAR __builtin_amdgcn_s_barrier()
#define PG8_SCHED __builtin_amdgcn_sched_barrier(0)
    Unit cur, nxt; int ui = 0;
    if (!S.next(0, cur)) return;
    f32x4 acc[2][2][4][2];
#pragma unroll
    for (int a = 0; a < 2; ++a)
#pragma unroll
        for (int b = 0; b < 2; ++b)
#pragma unroll
            for (int m = 0; m < 4; ++m)
#pragma unroll
                for (int n = 0; n < 2; ++n) acc[a][b][m][n] = (f32x4){0.f, 0.f, 0.f, 0.f};
    bf16x8 At[4][2], B0[2][2], B1[2][2];
    const char* cA = (const char*)g.A + (size_t)cur.pm * tstep + (size_t)cur.ko * 2; const char* cB = (const char*)g.Bt + (size_t)cur.pn * tstep + (size_t)cur.ko * 2;
    S.a_ready(cur);
    PG8_STAGE(PG8_SB(0, 0), cB, voffB); PG8_STAGE(PG8_SA(0, 0), cA, voffA); PG8_STAGE(PG8_SB(0, 1), cB + hstep, voffB); PG8_STAGE(PG8_SA(0, 1), cA + hstep, voffA);
    if (wr == 1) PG8_BAR;
    PG8_WAIT_V(4); PG8_BAR;
    PG8_STAGE(PG8_SB(1, 0), cB + kstep, voffB); PG8_STAGE(PG8_SA(1, 0), cA + kstep, voffA); PG8_STAGE(PG8_SB(1, 1), cB + hstep + kstep, voffB);
    PG8_WAIT_V(6); PG8_BAR;
    PG8_STAMP();
    for (;;) {
        const bool has_next = S.next(ui + 1, nxt);
        const char* nA = has_next ? (const char*)g.A + (size_t)nxt.pm * tstep + (size_t)nxt.ko * 2 : cA; const char* nB = has_next ? (const char*)g.Bt + (size_t)nxt.pn * tstep + (size_t)nxt.ko * 2 : cB;
#pragma unroll 1
        for (int t = 0; t < nt; t += 2) {
            const bool last = (t == nt - 2);
            const char* a1 = cA + (size_t)(t + 1) * kstep;
            const char* a2 = last ? nA : cA + (size_t)(t + 2) * kstep; const char* b2 = last ? nB : cB + (size_t)(t + 2) * kstep;
            const char* a3 = a2 + kstep; const char* b3 = b2 + kstep;
            if (last && has_next) S.a_ready(nxt);
            PG8_LDB(B0, 0, 0); PG8_SCHED; PG8_LDA(At, 0, 0); PG8_STAGE(PG8_SA(1, 1), a1 + hstep, voffA);
            PG8_WAIT_L(8); PG8_BAR; PG8_WAIT_L(0); PG8_MMA(0, 0, At, B0); PG8_BAR; PG8_SCHED;
            PG8_LDB(B1, 0, 1); PG8_STAGE(PG8_SB(0, 0), b2, voffB);
            PG8_BAR; PG8_WAIT_L(0); PG8_MMA(0, 1, At, B1); PG8_BAR;
            PG8_LDA(At, 0, 1); PG8_STAGE(PG8_SA(0, 0), a2, voffA);
            PG8_BAR; PG8_WAIT_L(0); PG8_MMA(1, 0, At, B0); PG8_BAR; PG8_SCHED;
            PG8_STAGE(PG8_SB(0, 1), b2 + hstep, voffB);
            PG8_WAIT_V(6); PG8_BAR; PG8_MMA(1, 1, At, B1); PG8_BAR;
            PG8_LDB(B0, 1, 0); PG8_SCHED; PG8_LDA(At, 1, 0); PG8_STAGE(PG8_SA(0, 1), a2 + hstep, voffA);
            PG8_WAIT_L(8); PG8_BAR; PG8_WAIT_L(0); PG8_MMA(0, 0, At, B0); PG8_BAR; PG8_SCHED;
            PG8_LDB(B1, 1, 1); PG8_STAGE(PG8_SB(1, 0), b3, voffB);
            PG8_BAR; PG8_WAIT_L(0); PG8_MMA(0, 1, At, B1); PG8_BAR;
            PG8_LDA(At, 1, 1); PG8_STAGE(PG8_SA(1, 0), a3, voffA);
            PG8_BAR; PG8_WAIT_L(0); PG8_MMA(1, 0, At, B0); PG8_BAR; PG8_SCHED;
            PG8_STAGE(PG8_SB(1, 1), b3 + hstep, voffB);
            PG8_WAIT_V(6); PG8_BAR; PG8_MMA(1, 1, At, B1); PG8_BAR;
        }
        PG8_STAMP();
        if constexpr (!Epi::AFTER_DRAIN) { E(acc, cur, wr, wc, fr, fq); S.done(cur); }
        PG8_STAMP();
        if (!has_next) break;
#pragma unroll
        for (int a = 0; a < 2; ++a)
#pragma unroll
            for (int b = 0; b < 2; ++b)
#pragma unroll
                for (int m = 0; m < 4; ++m)
#pragma unroll
                    for (int n = 0; n < 2; ++n) acc[a][b][m][n] = (f32x4){0.f, 0.f, 0.f, 0.f};
        cur = nxt; cA = nA; cB = nB; ++ui;
    }
    PG8_WAIT_V(0);
    if (wr == 0) PG8_BAR;
    PG8_BAR;
    if constexpr (Epi::AFTER_DRAIN) { E.fused(acc, cur, wr, wc, fr, fq, lds, wid, lane); S.done(cur); }
    PG8_STAMP();
    if (STAMP && wid == 0) { stamps[lane] = lane < nts ? (((unsigned long long)(unsigned)ts_hi << 32) | (unsigned)ts_lo) : 0ull;
        if (lane == 62) stamps[62] = rt_entry; if (lane == 63) stamps[63] = (unsigned long long)wall_clock64(); }
#undef PG8_STAMP
#undef PG8_SA
#undef PG8_SB
#undef PG8_STAGE
#undef PG8_LDA
#undef PG8_LDB
#undef PG8_MMA
#undef PG8_WAIT_V
#undef PG8_WAIT_L
#undef PG8_BAR
#undef PG8_SCHED
}
}

#define LAS __attribute__((address_space(3)))
typedef unsigned short bf16_t;
typedef short bf16x8 __attribute__((ext_vector_type(8)));
typedef float f32x4 __attribute__((ext_vector_type(4)));
typedef unsigned u32x4 __attribute__((ext_vector_type(4)));
typedef unsigned u32x2 __attribute__((ext_vector_type(2)));

constexpr int M_TOK = 16384, T_SEQ = 8192, DM = 4096, NPROJ = 10624, NPAD = 10752, FFD = 16384;
constexpr int GW = 2048, RW = 2048, PSW = 6528, LK = 384, LN_ = 6144;
constexpr int LDS_BYTES = 151568, NTHREADS = 512, NWAVES = 8;

constexpr size_t OFF_W1T = 0;
constexpr size_t OFF_W2T = OFF_W1T + (size_t)FFD * DM * 2;
constexpr size_t OFF_WOT = OFF_W2T + (size_t)FFD * DM * 2;
constexpr size_t OFF_BT2 = OFF_WOT + (size_t)DM * DM * 2;
constexpr size_t OFF_H   = OFF_BT2 + (size_t)LN_ * LK * 2;
constexpr size_t OFF_WIN = OFF_H + (size_t)M_TOK * DM * 2;
constexpr size_t OFF_Z   = OFF_WIN + (size_t)NPAD * DM * 2;
constexpr size_t OFF_PS  = OFF_Z + (size_t)M_TOK * DM * 2;
constexpr size_t OFF_Y   = OFF_PS + (size_t)M_TOK * PSW * 2;
constexpr size_t OFF_A2  = OFF_Y + (size_t)M_TOK * DM * 2;
constexpr size_t OFF_ST  = OFF_A2 + (size_t)M_TOK * LK * 2;
constexpr size_t OFF_SS1 = OFF_ST + (size_t)M_TOK * 8;
constexpr size_t OFF_SS2 = OFF_SS1 + (size_t)M_TOK * 64 * 4;
constexpr size_t OFF_BAR = OFF_SS2 + (size_t)M_TOK * 64 * 4;
constexpr size_t WS_END  = OFF_BAR + 16384;
constexpr size_t OFF_LO  = OFF_H;
constexpr size_t OFF_YRAW = OFF_Z;
constexpr size_t OFF_MIX = OFF_PS;
constexpr size_t OFF_HID = OFF_WIN;
constexpr size_t OFF_F   = OFF_H;
static_assert(OFF_HID + (size_t)M_TOK * FFD * 2 <= OFF_A2, "hid overflows");
static_assert(OFF_LO + (size_t)M_TOK * LN_ * 2 <= OFF_Z, "LO fits H + WinT");
static_assert(WS_END <= (size_t)1073741824, "workspace");

struct Params {
    const float* x; const float* pre_mix_g; const float* w_in; const float* mu; const float* ln_g; const float* ln_b;
    const float* ws; const float* bs; const float* w0; const float* w_up; const float* a0; const float* a_up; const float* g_up;
    const float* k_k; const float* k_a; const float* r_k; const float* lnx_g; const float* lnx_b; const float* w_out;
    const float* post_mix_g; const float* pre_ffn_g; const float* w_ff1; const float* w_ff2; const float* post_ffn_g;
    float* out; unsigned char* wsb; int ph_lo, ph_hi, coop, pad;
};

typedef float f32x2v_ __attribute__((ext_vector_type(2))); typedef __bf16 bf16x2v_ __attribute__((ext_vector_type(2)));
__device__ __forceinline__ unsigned pk2(float lo, float hi) { const f32x2v_ v = {lo, hi}; return __builtin_bit_cast(unsigned, __builtin_convertvector(v, bf16x2v_)); }
__device__ __forceinline__ float bflo(unsigned u) { return __uint_as_float(u << 16); }
__device__ __forceinline__ float bfhi(unsigned u) { return __uint_as_float(u & 0xffff0000u); }
__device__ __forceinline__ float bf1(bf16_t b) { return __uint_as_float(((unsigned)b) << 16); }
__device__ __forceinline__ bf16_t f2bf(float f) { return (bf16_t)(pk2(f, 0.f) & 0xffffu); }
__device__ __forceinline__ float wave_sum(float v) {
#pragma unroll
    for (int o = 1; o < 64; o <<= 1) v += __shfl_xor(v, o);
    return v;
}
template <int CTRL> __device__ __forceinline__ float dpp_mov(float x) { return __builtin_bit_cast(float, __builtin_amdgcn_update_dpp(0, __builtin_bit_cast(int, x), CTRL, 0xf, 0xf, true)); }
__device__ __forceinline__ float red16(float v) {
    v += dpp_mov<0xB1>(v);
    v += dpp_mov<0x4E>(v);
    v += dpp_mov<0x141>(v);
    v += dpp_mov<0x140>(v);
    return v;
}
#define LDS_WAIT() asm volatile("s_waitcnt lgkmcnt(0)" ::: "memory")

__device__ __forceinline__ float gelu_tanh(float x) {
    const float u = 0.7978845608028654f * (x + 0.044715f * x * x * x);
    const float e = __builtin_amdgcn_exp2f(-2.0f * 1.4426950408889634f * u);
    return x * __builtin_amdgcn_rcpf(1.0f + e);
}
struct EpiProj {
    static constexpr bool PERM = true, AFTER_DRAIN = false;
    bf16_t* Z; bf16_t* PS;
    __device__ __forceinline__ void operator()(const f32x4 (&acc)[2][2][4][2], const pg8::Unit& u, int wr, int wc, int fr, int fq) const {
        const int row0 = u.pm * 256 + wr * 64 + fr, colt = u.pn * 256 + wc * 32 + 8 * fq;
        const bool isz = u.pn < 16;
#pragma unroll
        for (int ai = 0; ai < 2; ++ai)
#pragma unroll
            for (int m = 0; m < 4; ++m) { const size_t row = (size_t)(row0 + ai * 128 + m * 16);
#pragma unroll
                for (int bj = 0; bj < 2; ++bj) { f32x4 v0 = acc[ai][bj][m][0], v1 = acc[ai][bj][m][1]; const int col = colt + bj * 128;
                    if (isz) {
#pragma unroll
                        for (int j = 0; j < 4; ++j) { v0[j] = gelu_tanh(v0[j]); v1[j] = gelu_tanh(v1[j]); }
                        u32x4 w; w.x = pk2(v0[0], v0[1]); w.y = pk2(v0[2], v0[3]); w.z = pk2(v1[0], v1[1]); w.w = pk2(v1[2], v1[3]);
                        *(u32x4*)(Z + row * DM + col) = w;
                    } else { const int c2 = col - 4096;
                        if (c2 < PSW) { u32x4 w; w.x = pk2(v0[0], v0[1]); w.y = pk2(v0[2], v0[3]); w.z = pk2(v1[0], v1[1]); w.w = pk2(v1[2], v1[3]);
                            *(u32x4*)(PS + row * PSW + c2) = w; } } } }
    }
};
__device__ __forceinline__ unsigned pkh2(float a, float b) { const _Float16 ha = (_Float16)a, hb = (_Float16)b; return (unsigned)__builtin_bit_cast(unsigned short, ha) | ((unsigned)__builtin_bit_cast(unsigned short, hb) << 16); }
__device__ __forceinline__ float decay_rate(float val) {
    const float xx = -val; const float sp = fmaxf(xx, 0.f) + __logf(1.0f + __expf(-fabsf(xx))); return __expf(-sp - 0.5f);
}
__device__ __forceinline__ float sigmoidf_(float v) { return __builtin_amdgcn_rcpf(1.0f + __expf(-v)); }
struct EpiF16 {
    static constexpr bool PERM = true, AFTER_DRAIN = false;
    unsigned short* O; const float* w0; const float* a0; int pn0;
    __device__ __forceinline__ void operator()(const f32x4 (&acc)[2][2][4][2], const pg8::Unit& u, int wr, int wc, int fr, int fq) const {
        const int pn = u.pn + pn0; const int row0 = u.pm * 256 + wr * 64 + fr, colt = pn * 256 + wc * 32 + 8 * fq;
        const int kind = pn >> 3;
        const float* bias = kind == 0 ? w0 : a0; const float scale = kind == 0 ? 0.6065306597126334f : 1.0f;
#pragma unroll
        for (int bj = 0; bj < 2; ++bj) { const int col = colt + bj * 128; f32x4 b0 = {0.f, 0.f, 0.f, 0.f}, b1 = b0;
            if (kind < 2) { b0 = *(const f32x4*)(bias + (col & 2047)); b1 = *(const f32x4*)(bias + (col & 2047) + 4); }
#pragma unroll
            for (int ai = 0; ai < 2; ++ai)
#pragma unroll
                for (int m = 0; m < 4; ++m) { const size_t row = (size_t)(row0 + ai * 128 + m * 16); f32x4 v0 = acc[ai][bj][m][0], v1 = acc[ai][bj][m][1];
                    if (kind < 2) {
#pragma unroll
                        for (int j = 0; j < 4; ++j) { v0[j] = scale * sigmoidf_(v0[j] + b0[j]); v1[j] = scale * sigmoidf_(v1[j] + b1[j]); } }
                    u32x4 w; w.x = pkh2(v0[0], v0[1]); w.y = pkh2(v0[2], v0[3]); w.z = pkh2(v1[0], v1[1]); w.w = pkh2(v1[2], v1[3]);
                    *(u32x4*)(O + row * LN_ + col) = w; asm volatile("" ::: "memory"); } }
    }
};
struct EpiNormPart {
    static constexpr bool PERM = true, AFTER_DRAIN = false;
    bf16_t* O; float* part;
    __device__ __forceinline__ void operator()(const f32x4 (&acc)[2][2][4][2], const pg8::Unit& u, int wr, int wc, int fr, int fq) const {
        const int row0 = u.pm * 256 + wr * 64 + fr, colt = u.pn * 256 + wc * 32 + 8 * fq;
#pragma unroll
        for (int ai = 0; ai < 2; ++ai)
#pragma unroll
            for (int m = 0; m < 4; ++m) { const size_t row = (size_t)(row0 + ai * 128 + m * 16); float s = 0.f;
#pragma unroll
                for (int bj = 0; bj < 2; ++bj) { const f32x4 v0 = acc[ai][bj][m][0], v1 = acc[ai][bj][m][1];
                    s += (v0[0] * v0[0] + v0[1] * v0[1]) + (v0[2] * v0[2] + v0[3] * v0[3]) + (v1[0] * v1[0] + v1[1] * v1[1]) + (v1[2] * v1[2] + v1[3] * v1[3]);
                    u32x4 w; w.x = pk2(v0[0], v0[1]); w.y = pk2(v0[2], v0[3]); w.z = pk2(v1[0], v1[1]); w.w = pk2(v1[2], v1[3]);
                    *(u32x4*)(O + row * DM + colt + bj * 128) = w; }
                s += __shfl_xor(s, 16); s += __shfl_xor(s, 32);
                if (fq == 0) part[row * 64 + u.pn * 4 + wc] = s; }
    }
};
struct EpiRelu2 {
    static constexpr bool PERM = true, AFTER_DRAIN = false;
    bf16_t* O;
    __device__ __forceinline__ void operator()(const f32x4 (&acc)[2][2][4][2], const pg8::Unit& u, int wr, int wc, int fr, int fq) const {
        const int row0 = u.pm * 256 + wr * 64 + fr, colt = u.pn * 256 + wc * 32 + 8 * fq;
#pragma unroll
        for (int ai = 0; ai < 2; ++ai)
#pragma unroll
            for (int m = 0; m < 4; ++m) { const size_t row = (size_t)(row0 + ai * 128 + m * 16);
#pragma unroll
                for (int bj = 0; bj < 2; ++bj) { f32x4 v0 = acc[ai][bj][m][0], v1 = acc[ai][bj][m][1];
#pragma unroll
                    for (int j = 0; j < 4; ++j) { const float a = fmaxf(v0[j], 0.f), b = fmaxf(v1[j], 0.f); v0[j] = a * a; v1[j] = b * b; }
                    u32x4 w; w.x = pk2(v0[0], v0[1]); w.y = pk2(v0[2], v0[3]); w.z = pk2(v1[0], v1[1]); w.w = pk2(v1[2], v1[3]);
                    *(u32x4*)(O + row * FFD + colt + bj * 128) = w; } }
    }
};

#define XB_TMO      128
#define XB_XCNT(j)  (256  + 64 * (j))
#define XB_XSUB(j)  (1280 + 64 * (j))
#define XB_XGEN(j)  (2304 + 64 * (j))
#define XB_TOP      3328
#define XB_TOPGEN   3392
#define XCD_BAR_WORDS 3456
#define XB_SPIN_CAP (1u << 18)
__device__ __forceinline__ unsigned xb_ld(unsigned* p)              { return __hip_atomic_load(p, __ATOMIC_RELAXED, __HIP_MEMORY_SCOPE_AGENT); }
__device__ __forceinline__ unsigned xb_add(unsigned* p, unsigned v) { return __hip_atomic_fetch_add(p, v, __ATOMIC_RELAXED, __HIP_MEMORY_SCOPE_AGENT); }
__device__ __forceinline__ unsigned xb_xcc_id() { return (unsigned)__builtin_amdgcn_s_getreg((3 << 11) | 20) & 0xFu; }
#define XB_SPIN(cond, bar) do { unsigned _sp = 0; while (cond) { __builtin_amdgcn_s_sleep(1); \
    if ((++_sp & 255u) == 0u) { if (xb_ld(&(bar)[XB_TMO])) break; if (_sp > XB_SPIN_CAP) { atomicAdd(&(bar)[XB_TMO], 1u); break; } } } } while (0)

struct XcdBarrier {
    unsigned* bar; unsigned x;
    volatile LAS unsigned* st;
};

__device__ __forceinline__ XcdBarrier xcd_barrier_post(unsigned* bar, volatile LAS unsigned* st) {
    XcdBarrier b; b.bar = bar; b.x = xb_xcc_id(); b.st = st;
    if (threadIdx.x == 0) (void)xb_add(&bar[XB_XCNT(b.x)], 1u);
    return b;
}
__device__ __forceinline__ void xcd_barrier_complete(unsigned* bar, unsigned x, unsigned& nloc, unsigned& nx) {
    const unsigned G = gridDim.x * gridDim.y * gridDim.z;
    unsigned sum, cnt, mine, sp = 0u;
    for (;;) {
        sum = 0u; cnt = 0u; mine = 0u;
#pragma unroll
        for (unsigned j = 0; j < 16; ++j) { const unsigned c = xb_ld(&bar[XB_XCNT(j)]); sum += c; cnt += (c > 0u) ? 1u : 0u; mine = (j == x) ? c : mine; }
        if (sum == G) break;
        __builtin_amdgcn_s_sleep(1);
        if ((++sp & 255u) == 0u) { if (xb_ld(&bar[XB_TMO])) break; if (sp > XB_SPIN_CAP) { atomicAdd(&bar[XB_TMO], 1u); break; } }
    }
    nloc = mine > 0u ? mine : 1u; nx = cnt > 0u ? cnt : 1u;
}

__device__ __forceinline__ void xcd_barrier(const XcdBarrier& b) {
    asm volatile("s_waitcnt vmcnt(0)" ::: "memory");
    __syncthreads();
    if (threadIdx.x == 0) {
        unsigned* bar = b.bar;
        __builtin_amdgcn_s_waitcnt(0);
        unsigned nloc = b.st[0], nx = b.st[1];
        if (nloc == 0u) { xcd_barrier_complete(bar, b.x, nloc, nx); b.st[0] = nloc; b.st[1] = nx; }
        const unsigned old = xb_add(&bar[XB_XSUB(b.x)], 1u);
        const unsigned gen = old / nloc;
        if (old + 1u == (gen + 1u) * nloc) {
            __builtin_amdgcn_fence(__ATOMIC_RELEASE, "agent");
            asm volatile("s_waitcnt vmcnt(0)" ::: "memory");
            const unsigned og = xb_add(&bar[XB_TOP], 1u);
            const unsigned tg = og / nx;
            if (og + 1u == (tg + 1u) * nx) xb_add(&bar[XB_TOPGEN], 1u);
            else XB_SPIN(xb_ld(&bar[XB_TOPGEN]) == tg, bar);
            __builtin_amdgcn_fence(__ATOMIC_ACQUIRE, "agent");
            xb_add(&bar[XB_XGEN(b.x)], 1u);
            asm volatile("s_waitcnt vmcnt(0)" ::: "memory");
        } else {
            XB_SPIN(xb_ld(&bar[XB_XGEN(b.x)]) == gen, bar);
            __builtin_amdgcn_fence(__ATOMIC_ACQUIRE, "agent");
            asm volatile("s_waitcnt vmcnt(0)" ::: "memory");
        }
    }
    __syncthreads();
}


typedef const __attribute__((address_space(4))) Params* KP;
__device__ __forceinline__ KP kparams() { unsigned long long q = (unsigned long long)__builtin_amdgcn_kernarg_segment_ptr(); asm volatile("" : "+s"(q) :: "memory"); return (KP)q; }
__device__ __forceinline__ void transpose_item(const float* W, int K, int N, bf16_t* WT, LAS float* scr, int item, int lane) {
    const int nblk = N / 32, kb = item / nblk, nb = item % nblk, k0 = 64 * kb, n0 = 32 * nb;
#pragma unroll 8
    for (int i = 0; i < 32; ++i) { const int kk = 2 * i + (lane >> 5); scr[kk * 33 + (lane & 31)] = W[(size_t)(k0 + kk) * N + n0 + (lane & 31)]; }
    LDS_WAIT();
    const int c = lane & 7;
#pragma unroll
    for (int j = 0; j < 4; ++j) { const int n = (lane >> 3) + 8 * j; const LAS float* s = scr + (8 * c) * 33 + n;
        u32x4 o; o.x = pk2(s[0 * 33], s[1 * 33]); o.y = pk2(s[2 * 33], s[3 * 33]); o.z = pk2(s[4 * 33], s[5 * 33]); o.w = pk2(s[6 * 33], s[7 * 33]);
        *(u32x4*)(WT + (size_t)(n0 + n) * K + k0 + 8 * c) = o; }
    LDS_WAIT();
}

__device__ __forceinline__ void phase0(KP p, unsigned char* lds, int gw, int NGW, int lane, int wave) {
    unsigned char* ws = p->wsb;
    LAS float* scr = (LAS float*)((LAS unsigned char*)lds + wave * 8448);
    bf16_t* WinT = (bf16_t*)(ws + OFF_WIN); bf16_t* WoT = (bf16_t*)(ws + OFF_WOT); bf16_t* W1T = (bf16_t*)(ws + OFF_W1T); bf16_t* W2T = (bf16_t*)(ws + OFF_W2T);
    constexpr int I_IN = (DM / 64) * (NPROJ / 32), I_O = (DM / 64) * (DM / 32), I_1 = (DM / 64) * (FFD / 32), I_2 = (FFD / 64) * (DM / 32);
    constexpr int NITEMS = I_IN;
    for (int it = gw; it < NITEMS; it += NGW) {
        int r = it;
        transpose_item(p->w_in, DM, NPROJ, WinT, scr, r, lane);
    }
    { u32x4* z = (u32x4*)(WinT + (size_t)NPROJ * DM); const size_t n16 = (size_t)(NPAD - NPROJ) * DM * 2 / 16; const u32x4 zero = {0u, 0u, 0u, 0u};
      for (size_t i = (size_t)gw * 64 + lane; i < n16; i += (size_t)NGW * 64) z[i] = zero; }
    { bf16_t* BT2 = (bf16_t*)(ws + OFF_BT2);
      for (size_t i = (size_t)gw * 64 + lane; i < (size_t)LN_ * LK; i += (size_t)NGW * 64) { const int n = (int)(i / LK), k = (int)(i % LK); float v = 0.f;
          if (n < 2048) { if (k < 64) v = p->w_up[(size_t)k * RW + n]; }
          else if (n < 4096) { if (k >= 64 && k < 128) v = p->a_up[(size_t)(k - 64) * RW + (n - 2048)]; }
          else { if (k >= 128) v = p->g_up[(size_t)(k - 128) * RW + (n - 4096)]; }
          BT2[i] = f2bf(v); } }
    bf16_t* H = (bf16_t*)(ws + OFF_H);
    for (int row = gw; row < M_TOK; row += NGW) {
        const float* gp0 = p->pre_mix_g; asm volatile("" : "+s"(gp0));
        const f32x4* xr = (const f32x4*)(p->x + (size_t)row * DM) + lane; f32x4 v[16]; float s = 0.f;
#pragma unroll
        for (int j = 0; j < 16; ++j) { v[j] = xr[64 * j]; s += (v[j].x * v[j].x + v[j].y * v[j].y) + (v[j].z * v[j].z + v[j].w * v[j].w); }
        const float rs = rsqrtf(wave_sum(s) * (1.0f / DM) + 1e-6f);
        u32x2* o = (u32x2*)(H + (size_t)row * DM) + lane;
#pragma unroll
        for (int j = 0; j < 16; ++j) { const f32x4 g = ((const f32x4*)gp0)[lane + 64 * j]; u32x2 w; w.x = pk2(v[j].x * rs * g.x, v[j].y * rs * g.y); w.y = pk2(v[j].z * rs * g.z, v[j].w * rs * g.w); o[64 * j] = w; }
    }
}

__device__ __forceinline__ void phase2(KP p, int gw, int NGW, int lane) {
    unsigned char* ws = p->wsb;
    const bf16_t* Z = (const bf16_t*)(ws + OFF_Z); const bf16_t* PS = (const bf16_t*)(ws + OFF_PS); bf16_t* A2 = (bf16_t*)(ws + OFF_A2); float* ST = (float*)(ws + OFF_ST);
    for (int row = gw; row < M_TOK; row += NGW) {
        const u32x4* zr = (const u32x4*)(Z + (size_t)row * DM + 2048) + lane; float v[32]; float s = 0.f;
#pragma unroll
        for (int j = 0; j < 4; ++j) { const u32x4 q = zr[64 * j];
            v[8 * j + 0] = bflo(q.x); v[8 * j + 1] = bfhi(q.x); v[8 * j + 2] = bflo(q.y); v[8 * j + 3] = bfhi(q.y); v[8 * j + 4] = bflo(q.z); v[8 * j + 5] = bfhi(q.z); v[8 * j + 6] = bflo(q.w); v[8 * j + 7] = bfhi(q.w); }
#pragma unroll
        for (int j = 0; j < 32; ++j) s += v[j];
        const float mean = wave_sum(s) * (1.0f / 2048.0f); float s2 = 0.f;
#pragma unroll
        for (int j = 0; j < 32; ++j) { const float d = v[j] - mean; s2 += d * d; }
        const float rstd = rsqrtf(wave_sum(s2) * (1.0f / 2048.0f) + 1e-5f);
        if (lane == 0) { ST[2 * row] = mean; ST[2 * row + 1] = rstd; }
        const bool has_prev = (row % T_SEQ) != 0;
#pragma unroll
        for (int i = 0; i < 6; ++i) { const int c = lane + 64 * i; const float cur = bf1(PS[(size_t)row * PSW + 6144 + c]);
            const float prev = has_prev ? bf1(PS[(size_t)(row - 1) * PSW + 6144 + c]) : 0.f; const float m = p->mu[6144 + c];
            float val = cur + (prev - cur) * m;
            if (i == 0) val = 1.0f - 2.0f * __builtin_amdgcn_rcpf(1.0f + __expf(2.0f * val));
            else if (i >= 2) val = sigmoidf_(val);
            A2[(size_t)row * LK + c] = f2bf(val); }
    }
}

__device__ __forceinline__ void phase_gmlp(KP p, unsigned char* ldsg, int tid, int lane, int wave) {
    unsigned char* ws = p->wsb;
    const bf16_t* Z = (const bf16_t*)(ws + OFF_Z); const float* ST = (const float*)(ws + OFF_ST); bf16_t* Y = (bf16_t*)(ws + OFF_Y);
    LAS bf16_t* Wm = (LAS bf16_t*)(LAS unsigned char*)ldsg; LAS bf16_t* Vt = Wm + 128 * 136;
    const int fr = lane & 15, fq = lane >> 4;
    const int si = tid >> 2, sb = (tid & 3) * 32;
    f32x4 wreg[8], greg[8], breg[8]; u32x4 zreg[4]; float mean = 0.f, rstd = 0.f;
#define GM_LOAD(UNIT) do { const int h_ = (UNIT) & 15, tok_ = ((UNIT) >> 4) * 128 + si; \
        const f32x4* wsrc_ = (const f32x4*)(p->ws + ((size_t)h_ * 128 + si) * 128 + sb); const u32x4* zsrc_ = (const u32x4*)(Z + (size_t)tok_ * DM + 2048 + h_ * 128 + sb); \
        const f32x4* gsrc_ = (const f32x4*)(p->ln_g + h_ * 128 + sb); const f32x4* bsrc_ = (const f32x4*)(p->ln_b + h_ * 128 + sb); \
        _Pragma("unroll") for (int q_ = 0; q_ < 8; ++q_) { wreg[q_] = wsrc_[q_]; greg[q_] = gsrc_[q_]; breg[q_] = bsrc_[q_]; } \
        _Pragma("unroll") for (int q_ = 0; q_ < 4; ++q_) zreg[q_] = zsrc_[q_]; \
        mean = ST[2 * tok_]; rstd = ST[2 * tok_ + 1]; } while (0)
    int unit = blockIdx.x;
    if (unit < 2048) GM_LOAD(unit);
    for (; unit < 2048; unit += gridDim.x) {
        const int h = unit & 15, bn = unit >> 4, tok0 = bn * 128;
        { const bool keep = (sb >> 6) <= (si >> 6);
#pragma unroll
          for (int q = 0; q < 4; ++q) { f32x4 a = wreg[2 * q], b = wreg[2 * q + 1]; if (!keep) { a = (f32x4){0.f, 0.f, 0.f, 0.f}; b = a; }
              u32x4 o; o.x = pk2(a.x, a.y); o.y = pk2(a.z, a.w); o.z = pk2(b.x, b.y); o.w = pk2(b.z, b.w); *(LAS u32x4*)(Wm + si * 136 + sb + 8 * q) = o; } }
        {
#pragma unroll
          for (int q = 0; q < 4; ++q) { const u32x4 z8 = zreg[q]; const float zf[8] = {bflo(z8.x), bfhi(z8.x), bflo(z8.y), bfhi(z8.y), bflo(z8.z), bfhi(z8.z), bflo(z8.w), bfhi(z8.w)};
              const f32x4 g0 = greg[2 * q], g1 = greg[2 * q + 1], b0 = breg[2 * q], b1 = breg[2 * q + 1];
#pragma unroll
              for (int e = 0; e < 8; ++e) { const float gg = e < 4 ? g0[e & 3] : g1[e & 3], bb = e < 4 ? b0[e & 3] : b1[e & 3];
                  Vt[(sb + 8 * q + e) * 136 + si] = f2bf((zf[e] - mean) * rstd * gg + bb); } } }
        __syncthreads();
        const int nxt = unit + gridDim.x;
        if (nxt < 2048) GM_LOAD(nxt);
        const int i0 = 16 * wave; const int tok = tok0 + i0 + fr; const float bias = p->bs[h * 128 + i0 + fr];
        u32x2 ureg[8];
#pragma unroll
        for (int ct = 0; ct < 8; ++ct) ureg[ct] = *(const u32x2*)(Z + (size_t)tok * DM + h * 128 + ct * 16 + 4 * fq);
        f32x4 acc[8];
#pragma unroll
        for (int ct = 0; ct < 8; ++ct) acc[ct] = (f32x4){0.f, 0.f, 0.f, 0.f};
        const int nks = (wave < 4) ? 2 : 4;
        for (int ks = 0; ks < nks; ++ks) { const bf16x8 wf = *(const LAS bf16x8*)(Wm + (i0 + fr) * 136 + ks * 32 + fq * 8);
#pragma unroll
            for (int ct = 0; ct < 8; ++ct) { const bf16x8 vf = *(const LAS bf16x8*)(Vt + (ct * 16 + fr) * 136 + ks * 32 + fq * 8);
                acc[ct] = __builtin_amdgcn_mfma_f32_16x16x32_bf16(vf, wf, acc[ct], 0, 0, 0); } }
#pragma unroll
        for (int ct = 0; ct < 8; ++ct) { const int c = h * 128 + ct * 16 + 4 * fq; const u32x2 uu = ureg[ct];
            u32x2 o; o.x = pk2(bflo(uu.x) * (acc[ct][0] + bias), bfhi(uu.x) * (acc[ct][1] + bias)); o.y = pk2(bflo(uu.y) * (acc[ct][2] + bias), bfhi(uu.y) * (acc[ct][3] + bias));
            *(u32x2*)(Y + (size_t)tok * DM + c) = o; }
        __syncthreads();
    }
#undef GM_LOAD
}

constexpr int BG_O = (DM / 64) * (DM / 64), BG_1 = (DM / 64) * (FFD / 64), BG_2 = (FFD / 64) * (DM / 64), BG_ITEMS = BG_O + BG_1 + BG_2;
struct BgRegs { float v[16]; };
__device__ __forceinline__ void bg_locate(KP p, int item, const float*& W, bf16_t*& WT, int& K, int& N, int& k0, int& n0) {
    unsigned char* ws = p->wsb; int r = item;
    if (r < BG_O) { W = p->w_out; WT = (bf16_t*)(ws + OFF_WOT); K = DM; N = DM; }
    else { r -= BG_O; if (r < BG_1) { W = p->w_ff1; WT = (bf16_t*)(ws + OFF_W1T); K = DM; N = FFD; } else { r -= BG_1; W = p->w_ff2; WT = (bf16_t*)(ws + OFF_W2T); K = FFD; N = DM; } }
    const int lg = (N == DM) ? 6 : 8; k0 = (r >> lg) * 64; n0 = (r & ((1 << lg) - 1)) * 64;
}
__device__ __forceinline__ void bg_load(KP p, BgRegs& R, int item, int w4, int lane) {
    const float* W; bf16_t* WT; int K, N, k0, n0; bg_locate(p, item, W, WT, K, N, k0, n0);
    const __amdgpu_buffer_rsrc_t rs = __builtin_amdgcn_make_buffer_rsrc((void*)W, 0, 0x7fffffff, 0x00020000);
    const unsigned vo = (unsigned)lane * 4u, sbase = (unsigned)(((k0 + 16 * w4) * N + n0) * 4), rowb = (unsigned)N * 4u;
#pragma unroll
    for (int i = 0; i < 16; ++i) R.v[i] = __builtin_bit_cast(float, __builtin_amdgcn_raw_buffer_load_b32(rs, vo, sbase + (unsigned)i * rowb, 0));
}
__device__ __forceinline__ void bg_store(KP p, const BgRegs& R, int item, int w4, int lane) {
    const float* W; bf16_t* WT; int K, N, k0, n0; bg_locate(p, item, W, WT, K, N, k0, n0);
    u32x4 a, b; a.x = pk2(R.v[0], R.v[1]); a.y = pk2(R.v[2], R.v[3]); a.z = pk2(R.v[4], R.v[5]); a.w = pk2(R.v[6], R.v[7]);
    b.x = pk2(R.v[8], R.v[9]); b.y = pk2(R.v[10], R.v[11]); b.z = pk2(R.v[12], R.v[13]); b.w = pk2(R.v[14], R.v[15]);
    u32x4* dst = (u32x4*)(WT + (size_t)(n0 + lane) * K + k0 + 16 * w4); dst[0] = a; dst[1] = b;
}
constexpr int SC = 32;
constexpr int SBUF = 43008, L_WW = 8192, L_BB = 16384, L_KP = 24576, L_RR = 32768, L_VV = 40960, L_YP = 2 * SBUF, YPB = 32768;
static_assert(L_YP + 2 * YPB <= LDS_BYTES, "scan LDS");
struct ScanConst { float mur[8], muk[8], muv[8], kk_[8], ka[8], w0[8], a0[8]; };
typedef _Float16 h8v __attribute__((ext_vector_type(8)));
struct ScanRaw { u32x4 rc, kc, vc, rp, kp_, vp; h8v e8, a8; };
__device__ __forceinline__ void scan_load(ScanRaw& R, const bf16_t* PS, const _Float16* LO, size_t tok, bool hasp, int hc) {
    const bf16_t* row = PS + tok * PSW + hc; const bf16_t* prow = row - PSW;
    const u32x4 zero = {0u, 0u, 0u, 0u};
    R.rc = *(const u32x4*)(row); R.kc = *(const u32x4*)(row + 2048); R.vc = *(const u32x4*)(row + 4096);
    R.rp = hasp ? *(const u32x4*)(prow) : zero; R.kp_ = hasp ? *(const u32x4*)(prow + 2048) : zero; R.vp = hasp ? *(const u32x4*)(prow + 4096) : zero;
    R.e8 = *(const h8v*)(LO + tok * LN_ + hc); R.a8 = *(const h8v*)(LO + tok * LN_ + 2048 + hc);
}
typedef __amdgpu_buffer_rsrc_t bufrsrc_t;
__device__ __forceinline__ bufrsrc_t make_rsrc(const void* p) { return __builtin_amdgcn_make_buffer_rsrc((void*)p, 0, 0x7fffffff, 0x00020000); }
struct ScanOff { unsigned r, k, v, e, a; };
__device__ __forceinline__ void scan_load_buf(ScanRaw& R, bufrsrc_t rsP, bufrsrc_t rsL, const ScanOff& o, unsigned soffP, unsigned soffL) {
    R.rc = __builtin_amdgcn_raw_buffer_load_b128(rsP, o.r, soffP, 0); R.kc = __builtin_amdgcn_raw_buffer_load_b128(rsP, o.k, soffP, 0); R.vc = __builtin_amdgcn_raw_buffer_load_b128(rsP, o.v, soffP, 0);
    const unsigned soffPp = soffP - (unsigned)(PSW * 2);
    R.rp = __builtin_amdgcn_raw_buffer_load_b128(rsP, o.r, soffPp, 0); R.kp_ = __builtin_amdgcn_raw_buffer_load_b128(rsP, o.k, soffPp, 0); R.vp = __builtin_amdgcn_raw_buffer_load_b128(rsP, o.v, soffPp, 0);
    R.e8 = __builtin_bit_cast(h8v, __builtin_amdgcn_raw_buffer_load_b128(rsL, o.e, soffL, 0)); R.a8 = __builtin_bit_cast(h8v, __builtin_amdgcn_raw_buffer_load_b128(rsL, o.a, soffL, 0));
}
__device__ __forceinline__ void scan_prep(LAS unsigned char* buf, const ScanConst& C, const ScanRaw& R, int pt, int kb, int q) {
    const u32x4 rc = R.rc, kc = R.kc, vc = R.vc, rp = R.rp, kp_ = R.kp_, vp = R.vp; const h8v e8 = R.e8, a8 = R.a8;
    float r[8], k[8], v[8], a[8], kk[8], wv[8], kq[8]; float ss = 0.f;
    const unsigned rcw[4] = {rc.x, rc.y, rc.z, rc.w}, rpw[4] = {rp.x, rp.y, rp.z, rp.w}, kcw[4] = {kc.x, kc.y, kc.z, kc.w}, kpw[4] = {kp_.x, kp_.y, kp_.z, kp_.w};
    const unsigned vcw[4] = {vc.x, vc.y, vc.z, vc.w}, vpw[4] = {vp.x, vp.y, vp.z, vp.w};
#pragma unroll
    for (int e = 0; e < 8; ++e) { const int wq = e >> 1; const bool hi = e & 1;
        const float rcf = hi ? bfhi(rcw[wq]) : bflo(rcw[wq]), rpf = hi ? bfhi(rpw[wq]) : bflo(rpw[wq]);
        const float kcf = hi ? bfhi(kcw[wq]) : bflo(kcw[wq]), kpf = hi ? bfhi(kpw[wq]) : bflo(kpw[wq]);
        const float vcf = hi ? bfhi(vcw[wq]) : bflo(vcw[wq]), vpf = hi ? bfhi(vpw[wq]) : bflo(vpw[wq]);
        r[e] = rcf + (rpf - rcf) * C.mur[e]; k[e] = kcf + (kpf - kcf) * C.muk[e]; v[e] = vcf + (vpf - vcf) * C.muv[e];
        a[e] = (float)a8[e];
        wv[e] = __expf(-(float)e8[e]);
        kk[e] = k[e] * C.kk_[e]; ss += kk[e] * kk[e];
        kq[e] = k[e] * (1.0f + (a[e] - 1.0f) * C.ka[e]); }
    ss += dpp_mov<0xB1>(ss); ss += dpp_mov<0x4E>(ss); ss += dpp_mov<0x141>(ss);
    const float inv = __builtin_amdgcn_rsqf(fmaxf(ss, 1e-24f));
#pragma unroll
    for (int e = 0; e < 8; ++e) kk[e] *= inv;
    LAS f32x4* d = (LAS f32x4*)(buf + pt * 256 + kb * 4);
    d[0] = (f32x4){kk[0], kk[1], kk[2], kk[3]}; d[1] = (f32x4){kk[4], kk[5], kk[6], kk[7]};
    d[L_WW / 16] = (f32x4){wv[0], wv[1], wv[2], wv[3]}; d[L_WW / 16 + 1] = (f32x4){wv[4], wv[5], wv[6], wv[7]};
    d[L_BB / 16] = (f32x4){kk[0] * a[0], kk[1] * a[1], kk[2] * a[2], kk[3] * a[3]}; d[L_BB / 16 + 1] = (f32x4){kk[4] * a[4], kk[5] * a[5], kk[6] * a[6], kk[7] * a[7]};
    d[L_KP / 16] = (f32x4){kq[0], kq[1], kq[2], kq[3]}; d[L_KP / 16 + 1] = (f32x4){kq[4], kq[5], kq[6], kq[7]};
    d[L_RR / 16] = (f32x4){r[0], r[1], r[2], r[3]}; d[L_RR / 16 + 1] = (f32x4){r[4], r[5], r[6], r[7]};
    if ((kb >> 4) == q) { LAS float* dv = (LAS float*)(buf + L_VV) + (kb & 15) * SC + pt;
#pragma unroll
        for (int e = 0; e < 8; ++e) dv[e * SC] = v[e]; }
}
__device__ __forceinline__ void scan_yreduce(const LAS unsigned char* ypb, float* YR, size_t tokbase, int colbase, int tid2) {
#pragma unroll
    for (int i = 0; i < 2; ++i) { const int o = tid2 + 256 * i, t = o >> 4, rw = o & 15;
        const LAS f32x4* s4 = (const LAS f32x4*)(ypb + (size_t)o * 64);
        const f32x4 a = s4[0], b = s4[1], c = s4[2], d = s4[3];
        const f32x4 z = (a + b) + (c + d);
        YR[(tokbase + t) * RW + colbase + rw] = (z.x + z.y) + (z.z + z.w); }
}
__device__ __forceinline__ void scan_consume(f32x4& S, const LAS unsigned char* buf, LAS unsigned char* ypb, int j, int rl, int wave, int lane) {
    const LAS f32x4* base = (const LAS f32x4*)(buf) + j;
    const LAS f32x4* vb4 = (const LAS f32x4*)(buf + L_VV) + rl * (SC / 4);
    LAS float* yp = (LAS float*)(ypb) + wave * 64 + lane;
    f32x4 kkq[3], wq[3], bq[3], kq[3], rq[3]; f32x4 vq4[2];
#pragma unroll
    for (int u = 0; u < 2; ++u) { kkq[u] = base[u * 16]; wq[u] = base[L_WW / 16 + u * 16]; bq[u] = base[L_BB / 16 + u * 16]; kq[u] = base[L_KP / 16 + u * 16]; rq[u] = base[L_RR / 16 + u * 16]; }
    vq4[0] = vb4[0];
#pragma unroll
    for (int t = 0; t < SC; ++t) {
        const int tn = (t + 2 < SC) ? t + 2 : SC - 1; const int sl = (t + 2) % 3, cu = t % 3;
        kkq[sl] = base[tn * 16]; wq[sl] = base[L_WW / 16 + tn * 16]; bq[sl] = base[L_BB / 16 + tn * 16]; kq[sl] = base[L_KP / 16 + tn * 16]; rq[sl] = base[L_RR / 16 + tn * 16];
        if ((t & 3) == 0 && t + 4 < SC) vq4[((t >> 2) + 1) & 1] = vb4[(t >> 2) + 1];
        const f32x4 kk4 = kkq[cu], w4 = wq[cu], b4 = bq[cu], k4 = kq[cu], r4 = rq[cu]; const float vv = vq4[(t >> 2) & 1][t & 3];
        float sa = fmaf(S.w, kk4.w, fmaf(S.z, kk4.z, fmaf(S.y, kk4.y, S.x * kk4.x)));
        const f32x4 vk = vv * k4;
        sa = -red16(sa);
        S = S * w4 + (sa * b4 + vk);
        yp[t * 256] = fmaf(S.w, r4.w, fmaf(S.z, r4.z, fmaf(S.y, r4.y, S.x * r4.x)));
    }
}
#define SCAN_BAR() do { asm volatile("s_waitcnt lgkmcnt(0)" ::: "memory"); __builtin_amdgcn_s_barrier(); asm volatile("" ::: "memory"); } while (0)
__device__ __forceinline__ void phase_scan(KP p, unsigned char* ldsg, int tid, int lane, int wave) {
    unsigned char* ws = p->wsb;
    const bf16_t* PS = (const bf16_t*)(ws + OFF_PS); const _Float16* LO = (const _Float16*)(ws + OFF_LO); float* YR = (float*)(ws + OFF_YRAW);
    LAS unsigned char* lds = (LAS unsigned char*)ldsg;
    const int G = gridDim.x, bx = blockIdx.x; const int vcu = (G % 8 == 0) ? (bx % 8) * (G / 8) + bx / 8 : bx;
    constexpr int NCH = T_SEQ / SC;
    int iter = 0;
    for (int su = vcu; su < 256; su += G, ++iter) {
        const int hp = su >> 2, q = su & 3, b = hp >> 5, h = hp & 31;
        const size_t tokb = (size_t)b * T_SEQ; const int colbase = h * 64 + q * 16;
#ifdef PROBE_ISO
        { f32x4 Sp = {0.f, 0.f, 0.f, 0.f};
          if (wave < 4) { for (int c = 0; c < PROBE_ISO; ++c) { scan_consume(Sp, lds, lds + L_YP, lane & 15, wave * 4 + (lane >> 4), wave, lane); asm volatile("" ::: "memory"); }
              if (Sp.x == 1.2345e-30f) YR[0] = Sp.y; }
          __syncthreads(); }
#endif
        if (wave >= 4) {
            const int tid2 = tid - 256, pt = tid2 >> 3, kb = (tid2 & 7) * 8, hc = h * 64 + kb;
            ScanConst C;
#pragma unroll
            for (int e = 0; e < 8; ++e) { C.mur[e] = p->mu[hc + e]; C.muk[e] = p->mu[2048 + hc + e]; C.muv[e] = p->mu[4096 + hc + e]; C.kk_[e] = p->k_k[hc + e]; C.ka[e] = p->k_a[hc + e]; C.w0[e] = p->w0[hc + e]; C.a0[e] = p->a0[hc + e]; }
            ScanRaw A, B;
            ScanOff so; so.r = (unsigned)(pt * PSW + hc) * 2u; so.k = so.r + 4096u; so.v = so.r + 8192u; so.e = (unsigned)(pt * LN_ + hc) * 2u; so.a = so.e + 4096u;
            const bufrsrc_t rsP = make_rsrc(PS), rsL = make_rsrc(LO);
            const unsigned pbase = (unsigned)(tokb * PSW * 2), lbase = (unsigned)(tokb * LN_ * 2);
            scan_load(A, PS, LO, tokb + pt, pt > 0, hc);
            scan_prep(lds, C, A, pt, kb, q);
            scan_load(A, PS, LO, tokb + SC + pt, true, hc);
            const int w4 = wave - 4; BgRegs BG; int bg_cur = -1;
            int bg_next = (iter * NCH) * G + bx;
            SCAN_BAR();
            for (int c = 0; c < NCH; ++c) {
                if (c + 1 < NCH) { B = A;
                    if (c + 2 < NCH) scan_load_buf(A, rsP, rsL, so, pbase + (unsigned)(c + 2) * (unsigned)(SC * PSW * 2), lbase + (unsigned)(c + 2) * (unsigned)(SC * LN_ * 2));
                    scan_prep(lds + ((c + 1) & 1) * SBUF, C, B, pt, kb, q); }
                if (c >= 1) scan_yreduce(lds + L_YP + ((c - 1) & 1) * YPB, YR, tokb + (size_t)(c - 1) * SC, colbase, tid2);
                if (bg_cur >= 0) { bg_store(p, BG, bg_cur, w4, lane); bg_cur = -1; }
                if (bg_next < BG_ITEMS) { bg_load(p, BG, bg_next, w4, lane); bg_cur = bg_next; }
                bg_next += G;
                SCAN_BAR();
            }
            if (bg_cur >= 0) bg_store(p, BG, bg_cur, w4, lane);
            scan_yreduce(lds + L_YP + ((NCH - 1) & 1) * YPB, YR, tokb + (size_t)(NCH - 1) * SC, colbase, tid2);
        } else {
            const int j = lane & 15, rl = wave * 4 + (lane >> 4);
            f32x4 S = {0.f, 0.f, 0.f, 0.f};
            __builtin_amdgcn_s_setprio(3);
            SCAN_BAR();
            for (int c = 0; c < NCH; ++c) {
                scan_consume(S, lds + (c & 1) * SBUF, lds + L_YP + (c & 1) * YPB, j, rl, wave, lane);
                SCAN_BAR();
            }
            __builtin_amdgcn_s_setprio(0);
        }
        __syncthreads();
    }
    if (wave >= 4) { BgRegs BG; for (int item = (iter * NCH) * G + bx; item < BG_ITEMS; item += G) { bg_load(p, BG, item, wave - 4, lane); bg_store(p, BG, item, wave - 4, lane); } }
}

__device__ __forceinline__ void phase_post(KP p, int gw, int NGW, int lane) {
    unsigned char* ws = p->wsb;
    const bf16_t* PS = (const bf16_t*)(ws + OFF_PS); const _Float16* LO = (const _Float16*)(ws + OFF_LO); const float* YR = (const float*)(ws + OFF_YRAW); bf16_t* Y = (bf16_t*)(ws + OFF_Y);
    for (int tok = gw; tok < M_TOK; tok += NGW) {
        const bool hasp = (tok % T_SEQ) != 0;
        const bf16_t* row = PS + (size_t)tok * PSW; const bf16_t* prow = row - PSW;
#pragma unroll 2
        for (int hg = 0; hg < 8; ++hg) { const int col = hg * 256 + lane * 4;
            const f32x4 y = *(const f32x4*)(YR + (size_t)tok * RW + col);
            const u32x2 z2 = {0u, 0u};
            const u32x2 rc = *(const u32x2*)(row + col), kc = *(const u32x2*)(row + 2048 + col), vc = *(const u32x2*)(row + 4096 + col);
            const u32x2 rp = hasp ? *(const u32x2*)(prow + col) : z2, kp = hasp ? *(const u32x2*)(prow + 2048 + col) : z2, vp = hasp ? *(const u32x2*)(prow + 4096 + col) : z2;
            const f32x4 mur = *(const f32x4*)(p->mu + col), muk = *(const f32x4*)(p->mu + 2048 + col), muv = *(const f32x4*)(p->mu + 4096 + col);
            typedef _Float16 h4 __attribute__((ext_vector_type(4))); const h4 a2 = *(const h4*)(LO + (size_t)tok * LN_ + 2048 + col), g2 = *(const h4*)(LO + (size_t)tok * LN_ + 4096 + col);
            const f32x4 ka = *(const f32x4*)(p->k_a + col), rk = *(const f32x4*)(p->r_k + col), lg = *(const f32x4*)(p->lnx_g + col), lb = *(const f32x4*)(p->lnx_b + col);
            const f32x4 rcf = {bflo(rc.x), bfhi(rc.x), bflo(rc.y), bfhi(rc.y)}, rpf = {bflo(rp.x), bfhi(rp.x), bflo(rp.y), bfhi(rp.y)};
            const f32x4 kcf = {bflo(kc.x), bfhi(kc.x), bflo(kc.y), bfhi(kc.y)}, kpf = {bflo(kp.x), bfhi(kp.x), bflo(kp.y), bfhi(kp.y)};
            const f32x4 vcf = {bflo(vc.x), bfhi(vc.x), bflo(vc.y), bfhi(vc.y)}, vpf = {bflo(vp.x), bfhi(vp.x), bflo(vp.y), bfhi(vp.y)};
            const f32x4 af = {(float)a2[0], (float)a2[1], (float)a2[2], (float)a2[3]}, gf = {(float)g2[0], (float)g2[1], (float)g2[2], (float)g2[3]};
            const f32x4 r = rcf + (rpf - rcf) * mur, k = kcf + (kpf - kcf) * muk, v = vcf + (vpf - vcf) * muv;
            const f32x4 kq = k * (1.0f + (af - 1.0f) * ka);
            const f32x4 rkk = r * kq * rk;
            const float bonus = red16((rkk.x + rkk.y) + (rkk.z + rkk.w));
            const float mean = red16((y.x + y.y) + (y.z + y.w)) * (1.0f / 64.0f);
            const f32x4 d = y - mean;
            const float var = red16((d.x * d.x + d.y * d.y) + (d.z * d.z + d.w * d.w)) * (1.0f / 64.0f);
            const float rstd = rsqrtf(var + 64e-5f);
            const f32x4 o = ((d * rstd) * lg + lb + bonus * v) * gf;
            u32x2 w; w.x = pk2(o.x, o.y); w.y = pk2(o.z, o.w);
            *(u32x2*)(Y + (size_t)tok * DM + 2048 + col) = w; }
    }
}

__device__ __forceinline__ void phase7(KP p, int gw, int NGW, int lane) {
    unsigned char* ws = p->wsb;
    const bf16_t* MIX = (const bf16_t*)(ws + OFF_MIX); const float* SS = (const float*)(ws + OFF_SS1); bf16_t* H = (bf16_t*)(ws + OFF_H);
    for (int row = gw; row < M_TOK; row += NGW) {
        const float* gp1 = p->post_mix_g; const float* gp2 = p->pre_ffn_g; asm volatile("" : "+s"(gp1), "+s"(gp2));
        const float rs1 = rsqrtf(wave_sum(SS[(size_t)row * 64 + lane]) * (1.0f / DM) + 1e-6f);
        const f32x4* xr = (const f32x4*)(p->x + (size_t)row * DM) + lane; const u32x2* mr = (const u32x2*)(MIX + (size_t)row * DM) + lane;
        u32x2* x1row = (u32x2*)(p->out + (size_t)row * DM) + lane; u32x2* hrow = (u32x2*)(H + (size_t)row * DM) + lane;
        f32x4 v[16]; float s = 0.f;
#pragma unroll
        for (int jh = 0; jh < 4; ++jh) {
            const f32x4* xg = xr + 256 * jh; const u32x2* mg = mr + 256 * jh; const f32x4* gg1 = (const f32x4*)gp1 + lane + 256 * jh; asm volatile("" : "+v"(xg), "+v"(mg), "+v"(gg1));
#pragma unroll
            for (int jj = 0; jj < 4; ++jj) { const int j = jh * 4 + jj; const f32x4 xx = xg[64 * jj]; const u32x2 mm = mg[64 * jj]; const f32x4 g = gg1[64 * jj];
                const f32x4 mf = {bflo(mm.x), bfhi(mm.x), bflo(mm.y), bfhi(mm.y)};
                v[j] = xx + (mf * rs1) * g; s += (v[j].x * v[j].x + v[j].y * v[j].y) + (v[j].z * v[j].z + v[j].w * v[j].w); }
            asm volatile("" ::: "memory"); }
        const float rs2 = rsqrtf(wave_sum(s) * (1.0f / DM) + 1e-6f);
#pragma unroll
        for (int jh = 0; jh < 4; ++jh) {
            u32x2* x1g = x1row + 256 * jh; u32x2* hg = hrow + 256 * jh; const f32x4* gg2 = (const f32x4*)gp2 + lane + 256 * jh; asm volatile("" : "+v"(x1g), "+v"(hg), "+v"(gg2));
#pragma unroll
            for (int jj = 0; jj < 4; ++jj) { const int j = jh * 4 + jj; const f32x4 g = gg2[64 * jj];
                u32x2 w; w.x = pk2(v[j].x, v[j].y); w.y = pk2(v[j].z, v[j].w); x1g[64 * jj] = w;
                u32x2 h; h.x = pk2(v[j].x * rs2 * g.x, v[j].y * rs2 * g.y); h.y = pk2(v[j].z * rs2 * g.z, v[j].w * rs2 * g.w); hg[64 * jj] = h; }
            asm volatile("" ::: "memory"); }
    }
}
__device__ __forceinline__ void phase10(KP p, int gw, int NGW, int lane) {
    unsigned char* ws = p->wsb;
    const bf16_t* F = (const bf16_t*)(ws + OFF_F); const float* SS = (const float*)(ws + OFF_SS2);
    for (int row = gw; row < M_TOK; row += NGW) {
        const float* gp3 = p->post_ffn_g; asm volatile("" : "+s"(gp3));
        const float rs = rsqrtf(wave_sum(SS[(size_t)row * 64 + lane]) * (1.0f / DM) + 1e-6f);
        f32x4* orow = (f32x4*)(p->out + (size_t)row * DM) + lane; const u32x2* x1row = (const u32x2*)(p->out + (size_t)row * DM) + lane; const u32x2* fr_ = (const u32x2*)(F + (size_t)row * DM) + lane;
        u32x2 xb[16], fb[16];
#pragma unroll
        for (int j = 0; j < 16; ++j) { xb[j] = x1row[64 * j]; fb[j] = fr_[64 * j]; }
        asm volatile("s_waitcnt vmcnt(0)" ::: "memory");
#pragma unroll
        for (int j = 0; j < 16; ++j) { const f32x4 g = ((const f32x4*)gp3)[lane + 64 * j];
            const f32x4 xx = {bflo(xb[j].x), bfhi(xb[j].x), bflo(xb[j].y), bfhi(xb[j].y)}, mf = {bflo(fb[j].x), bfhi(fb[j].x), bflo(fb[j].y), bfhi(fb[j].y)};
            orow[64 * j] = xx + (mf * rs) * g; }
    }
}

constexpr int NPHASE = 11;
__global__ void __launch_bounds__(NTHREADS, 2) fwd_megakernel(Params p_) {
    extern __shared__ __attribute__((aligned(16))) unsigned char lds[];
    const int tid = threadIdx.x, lane = tid & 63, wave = __builtin_amdgcn_readfirstlane(tid >> 6);
    const int G = gridDim.x, gw = blockIdx.x * NWAVES + wave, NGW = G * NWAVES;
    const int lo = p_.ph_lo, hi = p_.ph_hi;
    volatile LAS unsigned* xst = (volatile LAS unsigned*)((LAS unsigned char*)lds + (LDS_BYTES - 16));
    XcdBarrier xbar; xbar.bar = nullptr; xbar.x = 0; xbar.st = xst;
    if (p_.coop) { if (tid == 0) { xst[0] = 0u; xst[1] = 0u; } __syncthreads(); xbar = xcd_barrier_post((unsigned*)(p_.wsb + OFF_BAR), xst); }
    if (p_.coop == 2) cg::this_grid().sync();
#define GRIDBAR() xcd_barrier(xbar)
#ifndef PH_MASK
#define PH_MASK 0x7ff
#endif
#define IN(k) ((((PH_MASK) >> (k)) & 1) && lo <= (k) && (k) < hi)
#define SEAM(k) do { if (IN(k) && IN((k) + 1)) { GRIDBAR(); } } while (0)
#ifndef REPEAT_MASK
#define REPEAT_MASK 0
#endif
#define REPS(k) ((((REPEAT_MASK) >> (k)) & 1) ? 2 : 1)
#define RSYNC(k, r) do { if ((r) + 1 < REPS(k)) GRIDBAR(); } while (0)
    if (IN(0)) { for (int rep = 0; rep < REPS(0); ++rep) { KP p = kparams(); phase0(p, lds, gw, NGW, lane, wave); RSYNC(0, rep); } } SEAM(0);
    if (IN(1)) for (int rep = 0; rep < REPS(1); ++rep) { KP p = kparams(); unsigned char* ws = p->wsb; pg8::Gemm g{(const bf16_t*)(ws + OFF_H), (const bf16_t*)(ws + OFF_WIN), M_TOK, NPAD, DM, DM}; pg8::StaticOrder S; S.init(M_TOK, NPAD, G, (int)blockIdx.x);
        EpiProj E{(bf16_t*)(ws + OFF_Z), (bf16_t*)(ws + OFF_PS)};
        pg8::gemm_phase<EpiProj, pg8::StaticOrder>((PG8_LAS unsigned char*)lds, g, S, E, nullptr); RSYNC(1, rep); } SEAM(1);
    if (IN(2)) { for (int rep = 0; rep < REPS(2); ++rep) { KP p = kparams(); phase2(p, gw, NGW, lane); RSYNC(2, rep); } } SEAM(2);
    if (IN(3)) for (int rep = 0; rep < REPS(3); ++rep) { KP p = kparams(); unsigned char* ws = p->wsb; { pg8::Gemm g{(const bf16_t*)(ws + OFF_A2), (const bf16_t*)(ws + OFF_BT2), M_TOK, 4096, 256, LK}; pg8::StaticOrder S; S.init(M_TOK, 4096, G, (int)blockIdx.x, 0);
          EpiF16 E{(unsigned short*)(ws + OFF_LO), p->w0, p->a0, 0};
          pg8::gemm_phase<EpiF16, pg8::StaticOrder>((PG8_LAS unsigned char*)lds, g, S, E, nullptr); }
        { pg8::Gemm g{(const bf16_t*)(ws + OFF_A2), (const bf16_t*)(ws + OFF_BT2) + (size_t)4096 * LK, M_TOK, 2048, 256, LK}; pg8::StaticOrder S; S.init(M_TOK, 2048, G, (int)blockIdx.x, 128);
          EpiF16 E{(unsigned short*)(ws + OFF_LO), p->w0, p->a0, 16};
          pg8::gemm_phase<EpiF16, pg8::StaticOrder>((PG8_LAS unsigned char*)lds, g, S, E, nullptr); }
        __syncthreads();
        phase_gmlp(p, lds, tid, lane, wave); RSYNC(3, rep); } SEAM(3);
    if (IN(4)) { for (int rep = 0; rep < REPS(4); ++rep) { KP p = kparams(); phase_scan(p, lds, tid, lane, wave); RSYNC(4, rep); } } SEAM(4);
    if (IN(5)) { for (int rep = 0; rep < REPS(5); ++rep) { KP p = kparams(); phase_post(p, gw, NGW, lane); RSYNC(5, rep); } } SEAM(5);
    if (IN(6)) for (int rep = 0; rep < REPS(6); ++rep) { KP p = kparams(); unsigned char* ws = p->wsb; pg8::Gemm g{(const bf16_t*)(ws + OFF_Y), (const bf16_t*)(ws + OFF_WOT), M_TOK, DM, DM, DM}; pg8::StaticOrder S; S.init(M_TOK, DM, G, (int)blockIdx.x);
        EpiNormPart E{(bf16_t*)(ws + OFF_MIX), (float*)(ws + OFF_SS1)};
        pg8::gemm_phase<EpiNormPart, pg8::StaticOrder>((PG8_LAS unsigned char*)lds, g, S, E, nullptr); RSYNC(6, rep); } SEAM(6);
    if (IN(7)) { for (int rep = 0; rep < REPS(7); ++rep) { KP p = kparams(); phase7(p, gw, NGW, lane); RSYNC(7, rep); } } SEAM(7);
    if (IN(8)) for (int rep = 0; rep < REPS(8); ++rep) { KP p = kparams(); unsigned char* ws = p->wsb; pg8::Gemm g{(const bf16_t*)(ws + OFF_H), (const bf16_t*)(ws + OFF_W1T), M_TOK, FFD, DM, DM}; pg8::StaticOrder S; S.init(M_TOK, FFD, G, (int)blockIdx.x);
        EpiRelu2 E{(bf16_t*)(ws + OFF_HID)};
        pg8::gemm_phase<EpiRelu2, pg8::StaticOrder>((PG8_LAS unsigned char*)lds, g, S, E, nullptr); RSYNC(8, rep); } SEAM(8);
    if (IN(9)) for (int rep = 0; rep < REPS(9); ++rep) { KP p = kparams(); unsigned char* ws = p->wsb; pg8::Gemm g{(const bf16_t*)(ws + OFF_HID), (const bf16_t*)(ws + OFF_W2T), M_TOK, DM, FFD, FFD}; pg8::StaticOrder S; S.init(M_TOK, DM, G, (int)blockIdx.x);
        EpiNormPart E{(bf16_t*)(ws + OFF_F), (float*)(ws + OFF_SS2)};
        pg8::gemm_phase<EpiNormPart, pg8::StaticOrder>((PG8_LAS unsigned char*)lds, g, S, E, nullptr); RSYNC(9, rep); } SEAM(9);
    if (IN(10)) { KP p = kparams(); phase10(p, gw, NGW, lane); }
#undef IN
#undef SEAM
}

#ifndef N_LAUNCH_MODE
#define N_LAUNCH_MODE 1
#endif
extern "C" void kernel_launch(void* const* d_in, const int* in_sizes, int n_in, void* d_out, int out_size, void* d_ws, size_t ws_size, hipStream_t stream) {
    static int grid = 0;
    if (grid == 0) {
        int dev = 0, cus = 0, per_cu = 0;
        (void)hipGetDevice(&dev); (void)hipDeviceGetAttribute(&cus, hipDeviceAttributeMultiprocessorCount, dev);
        if (hipFuncSetAttribute((const void*)fwd_megakernel, hipFuncAttributeMaxDynamicSharedMemorySize, LDS_BYTES) != hipSuccess) fprintf(stderr, "hipFuncSetAttribute failed\n");
        if (hipOccupancyMaxActiveBlocksPerMultiprocessor(&per_cu, (const void*)fwd_megakernel, NTHREADS, LDS_BYTES) != hipSuccess || per_cu < 1) { fprintf(stderr, "occupancy query: %d\n", per_cu); per_cu = 1; }
        (void)hipGetLastError();
        grid = cus * 1;
        if (n_in != 24 || ws_size < WS_END) fprintf(stderr, "unexpected n_in %d / ws_size %zu (need %zu)\n", n_in, ws_size, (size_t)WS_END);
    }
    Params p{};
    const float** pp = (const float**)&p;
    for (int i = 0; i < 24; ++i) pp[i] = (const float*)d_in[i];
    p.out = (float*)d_out; p.wsb = (unsigned char*)d_ws; p.pad = 0;
#if N_LAUNCH_MODE == 1
    p.ph_lo = 0; p.ph_hi = NPHASE; p.coop = 1;
    (void)hipMemsetAsync((unsigned char*)d_ws + OFF_BAR, 0, 16384, stream);
    void* args[] = {&p};
    hipError_t e = hipLaunchCooperativeKernel((const void*)fwd_megakernel, dim3(grid), dim3(NTHREADS), args, LDS_BYTES, stream);
    if (e != hipSuccess) fprintf(stderr, "cooperative launch failed: %s (grid %d)\n", hipGetErrorString(e), grid);
#else
    for (int ph = 0; ph < NPHASE; ++ph) { p.ph_lo = ph; p.ph_hi = ph + 1; p.coop = 0;
        hipLaunchKernelGGL(fwd_megakernel, dim3(grid), dim3(NTHREADS), LDS_BYTES, stream, p); }
#endif
}
```

```cpp
#include <hip/hip_runtime.h>
#include <hip/hip_cooperative_groups.h>
#include <cstdio>
namespace cg = cooperative_groups;
namespace pg8 {
#define PG8_LAS __attribute__((address_space(3)))
typedef unsigned short bf16_t;
typedef short bf16x8 __attribute__((ext_vector_type(8)));
typedef float f32x4 __attribute__((ext_vector_type(4)));
typedef unsigned u32x4 __attribute__((ext_vector_type(4)));
constexpr int BM = 256, BK = 64, HALF = 128, HTB = HALF * BK * 2  , STAGE_BYTES = 8 * HTB, NXCD = 8, WGM = 8;

__host__ __device__ __forceinline__ int lds_byte(int r, int c) { const int st = (r >> 4) * 2 + (c >> 5), rr = r & 15, cc = c & 31, ob = rr * 64 + cc * 2; return st * 1024 + (ob ^ (((ob >> 9) & 1) << 5)); }
__host__ __device__ __forceinline__ void stage_rc(int b, int& R, int& C) { const int st = b / 1024, sb = b % 1024, swz = sb ^ (((sb >> 9) & 1) << 5); R = (st >> 1) * 16 + swz / 64; C = (st & 1) * 32 + (swz % 64) / 2; }
__host__ __device__ __forceinline__ int perm32(int rho) { const int n = rho >> 4, i = rho & 15; return 8 * (i >> 2) + 4 * n + (i & 3); }

struct Unit { int pm, pn; };
struct Gemm { const bf16_t* A; const bf16_t* Bt; int M, N, K; };

struct StaticOrder {
    int nM, nN, nwg, G, c;
    __host__ __device__ void init(int M, int N, int G_, int c_) { nM = M / BM; nN = N / BM; nwg = nM * nN; G = G_; c = c_; }
    __host__ __device__ bool next(int i, Unit& u) const {
        const long L = (long)i * G + c; if (L >= nwg) return false;
        int wgid = (int)L; { const int q = nwg / NXCD, r = nwg % NXCD, xcd = wgid % NXCD, off = wgid / NXCD; wgid = (xcd < r ? xcd * (q + 1) : r * (q + 1) + (xcd - r) * q) + off; }
        const int nig = WGM * nN, gid = wgid / nig, fm = gid * WGM, gsz = (nM - fm) < WGM ? (nM - fm) : WGM;
        u.pm = fm + ((wgid % nig) % gsz); u.pn = (wgid % nig) / gsz; return true;
    }
    __device__ __forceinline__ void a_ready(const Unit&) const {}
    __device__ __forceinline__ void done(const Unit&) const {}
};
__device__ __forceinline__ unsigned cvt_pk_bf16(float lo, float hi) { unsigned r; asm volatile("v_cvt_pk_bf16_f32 %0, %1, %2" : "=v"(r) : "v"(lo), "v"(hi)); return r; }
typedef float f32x2 __attribute__((ext_vector_type(2)));
template <class Epi, class Sched, bool STAMP = false>
__device__ __forceinline__ void gemm_phase(PG8_LAS unsigned char* lds, const Gemm g, const Sched& S, const Epi& E, unsigned long long* stamps) {
    const int tid = threadIdx.x, wid = __builtin_amdgcn_readfirstlane(tid >> 6), lane = tid & 63, wr = wid >> 2, wc = wid & 3, fr = lane & 15, fq = lane >> 4;
    const int K = g.K, nt = K / BK;
    int ts_lo = 0, ts_hi = 0, nts = 0; const unsigned long long rt_entry = STAMP ? (unsigned long long)wall_clock64() : 0ull;
#define PG8_STAMP() do { if (STAMP && wid == 0 && nts < 64) { const unsigned long long _c = (unsigned long long)clock64(); \
        ts_lo = (lane == nts) ? (int)(unsigned)_c : ts_lo; ts_hi = (lane == nts) ? (int)(unsigned)(_c >> 32) : ts_hi; ++nts; } } while (0)
    PG8_STAMP();
    unsigned voffA[2], voffB[2];
#pragma unroll
    for (int i = 0; i < 2; ++i) { int R, C; stage_rc(tid * 16 + i * 8192, R, C); const int Rb = Epi::PERM ? ((R & ~31) + perm32(R & 31)) : R;
        voffA[i] = (unsigned)(R * K + C) * 2u; voffB[i] = (unsigned)(Rb * K + C) * 2u; }
    const size_t kstep = (size_t)(BK * 2);
    const size_t hstep = (size_t)HALF * K * 2;
    const size_t tstep = 2 * hstep;
    const unsigned ldsw = (unsigned)wid * 1024u;
    const int aoff = lds_byte(wr * 64 + fr, fq * 8), boff = lds_byte(wc * 32 + fr, fq * 8);
#define PG8_SA(b, h) (((b) * 2 + (h)) * HTB)
#define PG8_SB(b, h) ((4 + (b) * 2 + (h)) * HTB)
#define PG8_STAGE(bufoff, gbase, voff) do { _Pragma("unroll") for (int _i = 0; _i < 2; ++_i) \
        __builtin_amdgcn_global_load_lds((const unsigned*)((const char*)(gbase) + (voff)[_i]), (PG8_LAS unsigned*)(lds + (bufoff) + ldsw + _i * 8192), 16, 0, 0); } while (0)
#define PG8_LDA(dst, b, h) do { _Pragma("unroll") for (int m = 0; m < 4; ++m) _Pragma("unroll") for (int k = 0; k < 2; ++k) dst[m][k] = *(const PG8_LAS bf16x8*)(lds + PG8_SA(b, h) + aoff + m * 2048 + k * 1024); } while (0)
#define PG8_LDB(dst, b, h) do { _Pragma("unroll") for (int n = 0; n < 2; ++n) _Pragma("unroll") for (int k = 0; k < 2; ++k) dst[n][k] = *(const PG8_LAS bf16x8*)(lds + PG8_SB(b, h) + boff + n * 2048 + k * 1024); } while (0)
#define PG8_MMA(ai, bj, At, Bt) do { __builtin_amdgcn_s_setprio(1); _Pragma("unroll") for (int m = 0; m < 4; ++m) _Pragma("unroll") for (int n = 0; n < 2; ++n) _Pragma("unroll") for (int k = 0; k < 2; ++k) \
        acc[ai][bj][m][n] = __builtin_amdgcn_mfma_f32_16x16x32_bf16(Bt[n][k], At[m][k], acc[ai][bj][m][n], 0, 0, 0); __builtin_amdgcn_s_setprio(0); } while (0)
#define PG8_WAIT_V(n) asm volatile("s_waitcnt vmcnt(" #n ")" ::: "memory")
#define PG8_WAIT_L(n) asm volatile("s_waitcnt lgkmcnt(" #n ")" ::: "memory")
#define PG8_BAR __builtin_amdgcn_s_barrier()
#define PG8_SCHED __builtin_amdgcn_sched_barrier(0)
    Unit cur, nxt; int ui = 0;
    if (!S.next(0, cur)) return;
    f32x4 acc[2][2][4][2];
#pragma unroll
    for (int a = 0; a < 2; ++a)
#pragma unroll
        for (int b = 0; b < 2; ++b)
#pragma unroll
            for (int m = 0; m < 4; ++m)
#pragma unroll
                for (int n = 0; n < 2; ++n) acc[a][b][m][n] = (f32x4){0.f, 0.f, 0.f, 0.f};
    bf16x8 At[4][2], B0[2][2], B1[2][2];
    const char* cA = (const char*)g.A + (size_t)cur.pm * tstep; const char* cB = (const char*)g.Bt + (size_t)cur.pn * tstep;
    S.a_ready(cur);
    PG8_STAGE(PG8_SB(0, 0), cB, voffB); PG8_STAGE(PG8_SA(0, 0), cA, voffA); PG8_STAGE(PG8_SB(0, 1), cB + hstep, voffB); PG8_STAGE(PG8_SA(0, 1), cA + hstep, voffA);
    if (wr == 1) PG8_BAR;
    PG8_WAIT_V(4); PG8_BAR;
    PG8_STAGE(PG8_SB(1, 0), cB + kstep, voffB); PG8_STAGE(PG8_SA(1, 0), cA + kstep, voffA); PG8_STAGE(PG8_SB(1, 1), cB + hstep + kstep, voffB);
    PG8_WAIT_V(6); PG8_BAR;
    PG8_STAMP();
    for (;;) {
        const bool has_next = S.next(ui + 1, nxt);
        const char* nA = has_next ? (const char*)g.A + (size_t)nxt.pm * tstep : cA; const char* nB = has_next ? (const char*)g.Bt + (size_t)nxt.pn * tstep : cB;
#pragma unroll 1
        for (int t = 0; t < nt; t += 2) {
            const bool last = (t == nt - 2);
            const char* a1 = cA + (size_t)(t + 1) * kstep;
            const char* a2 = last ? nA : cA + (size_t)(t + 2) * kstep; const char* b2 = last ? nB : cB + (size_t)(t + 2) * kstep;
            const char* a3 = a2 + kstep; const char* b3 = b2 + kstep;
            if (last && has_next) S.a_ready(nxt);
            PG8_LDB(B0, 0, 0); PG8_SCHED; PG8_LDA(At, 0, 0); PG8_STAGE(PG8_SA(1, 1), a1 + hstep, voffA);
            PG8_WAIT_L(8); PG8_BAR; PG8_WAIT_L(0); PG8_MMA(0, 0, At, B0); PG8_BAR; PG8_SCHED;
            PG8_LDB(B1, 0, 1); PG8_STAGE(PG8_SB(0, 0), b2, voffB);
            PG8_BAR; PG8_WAIT_L(0); PG8_MMA(0, 1, At, B1); PG8_BAR;
            PG8_LDA(At, 0, 1); PG8_STAGE(PG8_SA(0, 0), a2, voffA);
            PG8_BAR; PG8_WAIT_L(0); PG8_MMA(1, 0, At, B0); PG8_BAR; PG8_SCHED;
            PG8_STAGE(PG8_SB(0, 1), b2 + hstep, voffB);
            PG8_WAIT_V(6); PG8_BAR; PG8_MMA(1, 1, At, B1); PG8_BAR;
            PG8_LDB(B0, 1, 0); PG8_SCHED; PG8_LDA(At, 1, 0); PG8_STAGE(PG8_SA(0, 1), a2 + hstep, voffA);
            PG8_WAIT_L(8); PG8_BAR; PG8_WAIT_L(0); PG8_MMA(0, 0, At, B0); PG8_BAR; PG8_SCHED;
            PG8_LDB(B1, 1, 1); PG8_STAGE(PG8_SB(1, 0), b3, voffB);
            PG8_BAR; PG8_WAIT_L(0); PG8_MMA(0, 1, At, B1); PG8_BAR;
            PG8_LDA(At, 1, 1); PG8_STAGE(PG8_SA(1, 0), a3, voffA);
            PG8_BAR; PG8_WAIT_L(0); PG8_MMA(1, 0, At, B0); PG8_BAR; PG8_SCHED;
            PG8_STAGE(PG8_SB(1, 1), b3 + hstep, voffB);
            PG8_WAIT_V(6); PG8_BAR; PG8_MMA(1, 1, At, B1); PG8_BAR;
        }
        PG8_STAMP();
        if constexpr (!Epi::AFTER_DRAIN) { E(acc, cur, wr, wc, fr, fq); S.done(cur); }
        PG8_STAMP();
        if (!has_next) break;
#pragma unroll
        for (int a = 0; a < 2; ++a)
#pragma unroll
            for (int b = 0; b < 2; ++b)
#pragma unroll
                for (int m = 0; m < 4; ++m)
#pragma unroll
                    for (int n = 0; n < 2; ++n) acc[a][b][m][n] = (f32x4){0.f, 0.f, 0.f, 0.f};
        cur = nxt; cA = nA; cB = nB; ++ui;
    }
    PG8_WAIT_V(0);
    if (wr == 0) PG8_BAR;
    PG8_BAR;
    if constexpr (Epi::AFTER_DRAIN) { E.fused(acc, cur, wr, wc, fr, fq, lds, wid, lane); S.done(cur); }
    PG8_STAMP();
    if (STAMP && wid == 0) { stamps[lane] = lane < nts ? (((unsigned long long)(unsigned)ts_hi << 32) | (unsigned)ts_lo) : 0ull;
        if (lane == 62) stamps[62] = rt_entry; if (lane == 63) stamps[63] = (unsigned long long)wall_clock64(); }
#undef PG8_STAMP
#undef PG8_SA
#undef PG8_SB
#undef PG8_STAGE
#undef PG8_LDA
#undef PG8_LDB
#undef PG8_MMA
#undef PG8_WAIT_V
#undef PG8_WAIT_L
#undef PG8_BAR
#undef PG8_SCHED
}
}

#define LAS __attribute__((address_space(3)))
typedef unsigned short bf16_t;
typedef short bf16x8 __attribute__((ext_vector_type(8)));
typedef float f32x4 __attribute__((ext_vector_type(4)));
typedef unsigned u32x4 __attribute__((ext_vector_type(4)));
typedef unsigned u32x2 __attribute__((ext_vector_type(2)));

constexpr int M_TOK = 16384, T_SEQ = 8192, DM = 4096, NPROJ = 10624, NPAD = 10752, FFD = 16384;
constexpr int GW = 2048, RW = 2048, PSW = 6528, LK = 384, LN_ = 6144;
constexpr int LDS_BYTES = 151568, NTHREADS = 512, NWAVES = 8;

constexpr size_t OFF_W1T = 0;
constexpr size_t OFF_W2T = OFF_W1T + (size_t)FFD * DM * 2;
constexpr size_t OFF_WOT = OFF_W2T + (size_t)FFD * DM * 2;
constexpr size_t OFF_BT2 = OFF_WOT + (size_t)DM * DM * 2;
constexpr size_t OFF_H   = OFF_BT2 + (size_t)LN_ * LK * 2;
constexpr size_t OFF_WIN = OFF_H + (size_t)M_TOK * DM * 2;
constexpr size_t OFF_Z   = OFF_WIN + (size_t)NPAD * DM * 2;
constexpr size_t OFF_PS  = OFF_Z + (size_t)M_TOK * DM * 2;
constexpr size_t OFF_Y   = OFF_PS + (size_t)M_TOK * PSW * 2;
constexpr size_t OFF_A2  = OFF_Y + (size_t)M_TOK * DM * 2;
constexpr size_t OFF_ST  = OFF_A2 + (size_t)M_TOK * LK * 2;
constexpr size_t OFF_SS1 = OFF_ST + (size_t)M_TOK * 8;
constexpr size_t OFF_SS2 = OFF_SS1 + (size_t)M_TOK * 64 * 4;
constexpr size_t OFF_BAR = OFF_SS2 + (size_t)M_TOK * 64 * 4;
constexpr size_t WS_END  = OFF_BAR + 16384;
constexpr size_t OFF_BON = OFF_SS1;
constexpr size_t OFF_LO  = OFF_H;
constexpr size_t OFF_YRAW = OFF_Z;
constexpr size_t OFF_MIX = OFF_PS;
constexpr size_t OFF_HID = OFF_WIN;
constexpr size_t OFF_F   = OFF_H;
static_assert(OFF_HID + (size_t)M_TOK * FFD * 2 <= OFF_A2, "hid overflows");
static_assert(OFF_LO + (size_t)M_TOK * LN_ * 2 <= OFF_Z, "LO fits H + WinT");
static_assert(WS_END <= (size_t)1073741824, "workspace");

struct Params {
    const float* x; const float* pre_mix_g; const float* w_in; const float* mu; const float* ln_g; const float* ln_b;
    const float* ws; const float* bs; const float* w0; const float* w_up; const float* a0; const float* a_up; const float* g_up;
    const float* k_k; const float* k_a; const float* r_k; const float* lnx_g; const float* lnx_b; const float* w_out;
    const float* post_mix_g; const float* pre_ffn_g; const float* w_ff1; const float* w_ff2; const float* post_ffn_g;
    float* out; unsigned char* wsb; int ph_lo, ph_hi, coop, pad;
};

typedef float f32x2v_ __attribute__((ext_vector_type(2))); typedef __bf16 bf16x2v_ __attribute__((ext_vector_type(2)));
__device__ __forceinline__ unsigned pk2(float lo, float hi) { const f32x2v_ v = {lo, hi}; return __builtin_bit_cast(unsigned, __builtin_convertvector(v, bf16x2v_)); }
__device__ __forceinline__ float bflo(unsigned u) { return __uint_as_float(u << 16); }
__device__ __forceinline__ float bfhi(unsigned u) { return __uint_as_float(u & 0xffff0000u); }
__device__ __forceinline__ float bf1(bf16_t b) { return __uint_as_float(((unsigned)b) << 16); }
__device__ __forceinline__ bf16_t f2bf(float f) { return (bf16_t)(pk2(f, 0.f) & 0xffffu); }
__device__ __forceinline__ float wave_sum(float v) {
#pragma unroll
    for (int o = 1; o < 64; o <<= 1) v += __shfl_xor(v, o);
    return v;
}
template <int CTRL> __device__ __forceinline__ float dpp_mov(float x) { return __builtin_bit_cast(float, __builtin_amdgcn_update_dpp(0, __builtin_bit_cast(int, x), CTRL, 0xf, 0xf, true)); }
__device__ __forceinline__ float red16(float v) {
    v += dpp_mov<0xB1>(v);
    v += dpp_mov<0x4E>(v);
    v += dpp_mov<0x141>(v);
    v += dpp_mov<0x140>(v);
    return v;
}
#define LDS_WAIT() asm volatile("s_waitcnt lgkmcnt(0)" ::: "memory")

__device__ __forceinline__ float gelu_tanh(float x) {
    const float u = 0.7978845608028654f * (x + 0.044715f * x * x * x);
    const float e = __builtin_amdgcn_exp2f(-2.0f * 1.4426950408889634f * u);
    return x * __builtin_amdgcn_rcpf(1.0f + e);
}
struct EpiProj {
    static constexpr bool PERM = true, AFTER_DRAIN = false;
    bf16_t* Z; bf16_t* PS;
    __device__ __forceinline__ void operator()(const f32x4 (&acc)[2][2][4][2], const pg8::Unit& u, int wr, int wc, int fr, int fq) const {
        const int row0 = u.pm * 256 + wr * 64 + fr, colt = u.pn * 256 + wc * 32 + 8 * fq;
        const bool isz = u.pn < 16;
#pragma unroll
        for (int ai = 0; ai < 2; ++ai)
#pragma unroll
            for (int m = 0; m < 4; ++m) { const size_t row = (size_t)(row0 + ai * 128 + m * 16);
#pragma unroll
                for (int bj = 0; bj < 2; ++bj) { f32x4 v0 = acc[ai][bj][m][0], v1 = acc[ai][bj][m][1]; const int col = colt + bj * 128;
                    if (isz) {
#pragma unroll
                        for (int j = 0; j < 4; ++j) { v0[j] = gelu_tanh(v0[j]); v1[j] = gelu_tanh(v1[j]); }
                        u32x4 w; w.x = pk2(v0[0], v0[1]); w.y = pk2(v0[2], v0[3]); w.z = pk2(v1[0], v1[1]); w.w = pk2(v1[2], v1[3]);
                        *(u32x4*)(Z + row * DM + col) = w;
                    } else { const int c2 = col - 4096;
                        if (c2 < PSW) { u32x4 w; w.x = pk2(v0[0], v0[1]); w.y = pk2(v0[2], v0[3]); w.z = pk2(v1[0], v1[1]); w.w = pk2(v1[2], v1[3]);
                            *(u32x4*)(PS + row * PSW + c2) = w; } } } }
    }
};
__device__ __forceinline__ unsigned pkh2(float a, float b) { const _Float16 ha = (_Float16)a, hb = (_Float16)b; return (unsigned)__builtin_bit_cast(unsigned short, ha) | ((unsigned)__builtin_bit_cast(unsigned short, hb) << 16); }
__device__ __forceinline__ float decay_rate(float val) {
    const float xx = -val; const float sp = fmaxf(xx, 0.f) + __logf(1.0f + __expf(-fabsf(xx))); return __expf(-sp - 0.5f);
}
__device__ __forceinline__ float sigmoidf_(float v) { return __builtin_amdgcn_rcpf(1.0f + __expf(-v)); }
struct EpiF16 {
    static constexpr bool PERM = true, AFTER_DRAIN = false;
    unsigned short* O; const float* w0; const float* a0;
    __device__ __forceinline__ void operator()(const f32x4 (&acc)[2][2][4][2], const pg8::Unit& u, int wr, int wc, int fr, int fq) const {
        const int row0 = u.pm * 256 + wr * 64 + fr, colt = u.pn * 256 + wc * 32 + 8 * fq;
        const int kind = u.pn >> 3;
        const float* bias = kind == 0 ? w0 : a0; const float scale = kind == 0 ? 0.6065306597126334f : 1.0f;
#pragma unroll
        for (int bj = 0; bj < 2; ++bj) { const int col = colt + bj * 128; f32x4 b0 = {0.f, 0.f, 0.f, 0.f}, b1 = b0;
            if (kind < 2) { b0 = *(const f32x4*)(bias + (col & 2047)); b1 = *(const f32x4*)(bias + (col & 2047) + 4); }
#pragma unroll
            for (int ai = 0; ai < 2; ++ai)
#pragma unroll
                for (int m = 0; m < 4; ++m) { const size_t row = (size_t)(row0 + ai * 128 + m * 16); f32x4 v0 = acc[ai][bj][m][0], v1 = acc[ai][bj][m][1];
                    if (kind < 2) {
#pragma unroll
                        for (int j = 0; j < 4; ++j) { v0[j] = scale * sigmoidf_(v0[j] + b0[j]); v1[j] = scale * sigmoidf_(v1[j] + b1[j]); } }
                    u32x4 w; w.x = pkh2(v0[0], v0[1]); w.y = pkh2(v0[2], v0[3]); w.z = pkh2(v1[0], v1[1]); w.w = pkh2(v1[2], v1[3]);
                    *(u32x4*)(O + row * LN_ + col) = w; asm volatile("" ::: "memory"); } }
    }
};
struct EpiNormPart {
    static constexpr bool PERM = true, AFTER_DRAIN = false;
    bf16_t* O; float* part;
    __device__ __forceinline__ void operator()(const f32x4 (&acc)[2][2][4][2], const pg8::Unit& u, int wr, int wc, int fr, int fq) const {
        const int row0 = u.pm * 256 + wr * 64 + fr, colt = u.pn * 256 + wc * 32 + 8 * fq;
#pragma unroll
        for (int ai = 0; ai < 2; ++ai)
#pragma unroll
            for (int m = 0; m < 4; ++m) { const size_t row = (size_t)(row0 + ai * 128 + m * 16); float s = 0.f;
#pragma unroll
                for (int bj = 0; bj < 2; ++bj) { const f32x4 v0 = acc[ai][bj][m][0], v1 = acc[ai][bj][m][1];
                    s += (v0[0] * v0[0] + v0[1] * v0[1]) + (v0[2] * v0[2] + v0[3] * v0[3]) + (v1[0] * v1[0] + v1[1] * v1[1]) + (v1[2] * v1[2] + v1[3] * v1[3]);
                    u32x4 w; w.x = pk2(v0[0], v0[1]); w.y = pk2(v0[2], v0[3]); w.z = pk2(v1[0], v1[1]); w.w = pk2(v1[2], v1[3]);
                    *(u32x4*)(O + row * DM + colt + bj * 128) = w; }
                s += __shfl_xor(s, 16); s += __shfl_xor(s, 32);
                if (fq == 0) part[row * 64 + u.pn * 4 + wc] = s; }
    }
};
struct EpiRelu2 {
    static constexpr bool PERM = true, AFTER_DRAIN = false;
    bf16_t* O;
    __device__ __forceinline__ void operator()(const f32x4 (&acc)[2][2][4][2], const pg8::Unit& u, int wr, int wc, int fr, int fq) const {
        const int row0 = u.pm * 256 + wr * 64 + fr, colt = u.pn * 256 + wc * 32 + 8 * fq;
#pragma unroll
        for (int ai = 0; ai < 2; ++ai)
#pragma unroll
            for (int m = 0; m < 4; ++m) { const size_t row = (size_t)(row0 + ai * 128 + m * 16);
#pragma unroll
                for (int bj = 0; bj < 2; ++bj) { f32x4 v0 = acc[ai][bj][m][0], v1 = acc[ai][bj][m][1];
#pragma unroll
                    for (int j = 0; j < 4; ++j) { const float a = fmaxf(v0[j], 0.f), b = fmaxf(v1[j], 0.f); v0[j] = a * a; v1[j] = b * b; }
                    u32x4 w; w.x = pk2(v0[0], v0[1]); w.y = pk2(v0[2], v0[3]); w.z = pk2(v1[0], v1[1]); w.w = pk2(v1[2], v1[3]);
                    *(u32x4*)(O + row * FFD + colt + bj * 128) = w; } }
    }
};

#define XB_TMO      128
#define XB_XCNT(j)  (256  + 64 * (j))
#define XB_XSUB(j)  (1280 + 64 * (j))
#define XB_XGEN(j)  (2304 + 64 * (j))
#define XB_TOP      3328
#define XB_TOPGEN   3392
#define XCD_BAR_WORDS 3456
#define XB_SPIN_CAP (1u << 18)
__device__ __forceinline__ unsigned xb_ld(unsigned* p)              { return __hip_atomic_load(p, __ATOMIC_RELAXED, __HIP_MEMORY_SCOPE_AGENT); }
__device__ __forceinline__ unsigned xb_add(unsigned* p, unsigned v) { return __hip_atomic_fetch_add(p, v, __ATOMIC_RELAXED, __HIP_MEMORY_SCOPE_AGENT); }
__device__ __forceinline__ unsigned xb_xcc_id() { return (unsigned)__builtin_amdgcn_s_getreg((3 << 11) | 20) & 0xFu; }
#define XB_SPIN(cond, bar) do { unsigned _sp = 0; while (cond) { __builtin_amdgcn_s_sleep(1); \
    if ((++_sp & 255u) == 0u) { if (xb_ld(&(bar)[XB_TMO])) break; if (_sp > XB_SPIN_CAP) { atomicAdd(&(bar)[XB_TMO], 1u); break; } } } } while (0)

struct XcdBarrier {
    unsigned* bar; unsigned x;
    volatile LAS unsigned* st;
};

__device__ __forceinline__ XcdBarrier xcd_barrier_post(unsigned* bar, volatile LAS unsigned* st) {
    XcdBarrier b; b.bar = bar; b.x = xb_xcc_id(); b.st = st;
    if (threadIdx.x == 0) (void)xb_add(&bar[XB_XCNT(b.x)], 1u);
    return b;
}
__device__ __forceinline__ void xcd_barrier_complete(unsigned* bar, unsigned x, unsigned& nloc, unsigned& nx) {
    const unsigned G = gridDim.x * gridDim.y * gridDim.z;
    unsigned sum, cnt, mine, sp = 0u;
    for (;;) {
        sum = 0u; cnt = 0u; mine = 0u;
#pragma unroll
        for (unsigned j = 0; j < 16; ++j) { const unsigned c = xb_ld(&bar[XB_XCNT(j)]); sum += c; cnt += (c > 0u) ? 1u : 0u; mine = (j == x) ? c : mine; }
        if (sum == G) break;
        __builtin_amdgcn_s_sleep(1);
        if ((++sp & 255u) == 0u) { if (xb_ld(&bar[XB_TMO])) break; if (sp > XB_SPIN_CAP) { atomicAdd(&bar[XB_TMO], 1u); break; } }
    }
    nloc = mine > 0u ? mine : 1u; nx = cnt > 0u ? cnt : 1u;
}

__device__ __forceinline__ void xcd_barrier(const XcdBarrier& b) {
    asm volatile("s_waitcnt vmcnt(0)" ::: "memory");
    __syncthreads();
    if (threadIdx.x == 0) {
        unsigned* bar = b.bar;
        __builtin_amdgcn_s_waitcnt(0);
        unsigned nloc = b.st[0], nx = b.st[1];
        if (nloc == 0u) { xcd_barrier_complete(bar, b.x, nloc, nx); b.st[0] = nloc; b.st[1] = nx; }
        const unsigned old = xb_add(&bar[XB_XSUB(b.x)], 1u);
        const unsigned gen = old / nloc;
        if (old + 1u == (gen + 1u) * nloc) {
            __builtin_amdgcn_fence(__ATOMIC_RELEASE, "agent");
            asm volatile("s_waitcnt vmcnt(0)" ::: "memory");
            const unsigned og = xb_add(&bar[XB_TOP], 1u);
            const unsigned tg = og / nx;
            if (og + 1u == (tg + 1u) * nx) xb_add(&bar[XB_TOPGEN], 1u);
            else XB_SPIN(xb_ld(&bar[XB_TOPGEN]) == tg, bar);
            __builtin_amdgcn_fence(__ATOMIC_ACQUIRE, "agent");
            xb_add(&bar[XB_XGEN(b.x)], 1u);
            asm volatile("s_waitcnt vmcnt(0)" ::: "memory");
        } else {
            XB_SPIN(xb_ld(&bar[XB_XGEN(b.x)]) == gen, bar);
            __builtin_amdgcn_fence(__ATOMIC_ACQUIRE, "agent");
            asm volatile("s_waitcnt vmcnt(0)" ::: "memory");
        }
    }
    __syncthreads();
}


typedef const __attribute__((address_space(4))) Params* KP;
__device__ __forceinline__ KP kparams() { unsigned long long q = (unsigned long long)__builtin_amdgcn_kernarg_segment_ptr(); asm volatile("" : "+s"(q) :: "memory"); return (KP)q; }
__device__ __forceinline__ void transpose_item(const float* W, int K, int N, bf16_t* WT, LAS float* scr, int item, int lane) {
    const int nblk = N / 32, kb = item / nblk, nb = item % nblk, k0 = 64 * kb, n0 = 32 * nb;
#pragma unroll 8
    for (int i = 0; i < 32; ++i) { const int kk = 2 * i + (lane >> 5); scr[kk * 33 + (lane & 31)] = W[(size_t)(k0 + kk) * N + n0 + (lane & 31)]; }
    LDS_WAIT();
    const int c = lane & 7;
#pragma unroll
    for (int j = 0; j < 4; ++j) { const int n = (lane >> 3) + 8 * j; const LAS float* s = scr + (8 * c) * 33 + n;
        u32x4 o; o.x = pk2(s[0 * 33], s[1 * 33]); o.y = pk2(s[2 * 33], s[3 * 33]); o.z = pk2(s[4 * 33], s[5 * 33]); o.w = pk2(s[6 * 33], s[7 * 33]);
        *(u32x4*)(WT + (size_t)(n0 + n) * K + k0 + 8 * c) = o; }
    LDS_WAIT();
}

__device__ __forceinline__ void phase0(KP p, unsigned char* lds, int gw, int NGW, int lane, int wave) {
    unsigned char* ws = p->wsb;
    LAS float* scr = (LAS float*)((LAS unsigned char*)lds + wave * 8448);
    bf16_t* WinT = (bf16_t*)(ws + OFF_WIN); bf16_t* WoT = (bf16_t*)(ws + OFF_WOT); bf16_t* W1T = (bf16_t*)(ws + OFF_W1T); bf16_t* W2T = (bf16_t*)(ws + OFF_W2T);
    constexpr int I_IN = (DM / 64) * (NPROJ / 32), I_O = (DM / 64) * (DM / 32), I_1 = (DM / 64) * (FFD / 32), I_2 = (FFD / 64) * (DM / 32);
    constexpr int NITEMS = I_IN;
    for (int it = gw; it < NITEMS; it += NGW) {
        int r = it;
        transpose_item(p->w_in, DM, NPROJ, WinT, scr, r, lane);
    }
    { u32x4* z = (u32x4*)(WinT + (size_t)NPROJ * DM); const size_t n16 = (size_t)(NPAD - NPROJ) * DM * 2 / 16; const u32x4 zero = {0u, 0u, 0u, 0u};
      for (size_t i = (size_t)gw * 64 + lane; i < n16; i += (size_t)NGW * 64) z[i] = zero; }
    { bf16_t* BT2 = (bf16_t*)(ws + OFF_BT2);
      for (size_t i = (size_t)gw * 64 + lane; i < (size_t)LN_ * LK; i += (size_t)NGW * 64) { const int n = (int)(i / LK), k = (int)(i % LK); float v = 0.f;
          if (n < 2048) { if (k < 64) v = p->w_up[(size_t)k * RW + n]; }
          else if (n < 4096) { if (k >= 64 && k < 128) v = p->a_up[(size_t)(k - 64) * RW + (n - 2048)]; }
          else { if (k >= 128) v = p->g_up[(size_t)(k - 128) * RW + (n - 4096)]; }
          BT2[i] = f2bf(v); } }
    bf16_t* H = (bf16_t*)(ws + OFF_H);
    for (int row = gw; row < M_TOK; row += NGW) {
        const float* gp0 = p->pre_mix_g; asm volatile("" : "+s"(gp0));
        const f32x4* xr = (const f32x4*)(p->x + (size_t)row * DM) + lane; f32x4 v[16]; float s = 0.f;
#pragma unroll
        for (int j = 0; j < 16; ++j) { v[j] = xr[64 * j]; s += (v[j].x * v[j].x + v[j].y * v[j].y) + (v[j].z * v[j].z + v[j].w * v[j].w); }
        const float rs = rsqrtf(wave_sum(s) * (1.0f / DM) + 1e-6f);
        u32x2* o = (u32x2*)(H + (size_t)row * DM) + lane;
#pragma unroll
        for (int j = 0; j < 16; ++j) { const f32x4 g = ((const f32x4*)gp0)[lane + 64 * j]; u32x2 w; w.x = pk2(v[j].x * rs * g.x, v[j].y * rs * g.y); w.y = pk2(v[j].z * rs * g.z, v[j].w * rs * g.w); o[64 * j] = w; }
    }
}

__device__ __forceinline__ void phase2(KP p, int gw, int NGW, int lane) {
    unsigned char* ws = p->wsb;
    const bf16_t* Z = (const bf16_t*)(ws + OFF_Z); const bf16_t* PS = (const bf16_t*)(ws + OFF_PS); bf16_t* A2 = (bf16_t*)(ws + OFF_A2); float* ST = (float*)(ws + OFF_ST);
    for (int row = gw; row < M_TOK; row += NGW) {
        const u32x4* zr = (const u32x4*)(Z + (size_t)row * DM + 2048) + lane; float v[32]; float s = 0.f;
#pragma unroll
        for (int j = 0; j < 4; ++j) { const u32x4 q = zr[64 * j];
            v[8 * j + 0] = bflo(q.x); v[8 * j + 1] = bfhi(q.x); v[8 * j + 2] = bflo(q.y); v[8 * j + 3] = bfhi(q.y); v[8 * j + 4] = bflo(q.z); v[8 * j + 5] = bfhi(q.z); v[8 * j + 6] = bflo(q.w); v[8 * j + 7] = bfhi(q.w); }
#pragma unroll
        for (int j = 0; j < 32; ++j) s += v[j];
        const float mean = wave_sum(s) * (1.0f / 2048.0f); float s2 = 0.f;
#pragma unroll
        for (int j = 0; j < 32; ++j) { const float d = v[j] - mean; s2 += d * d; }
        const float rstd = rsqrtf(wave_sum(s2) * (1.0f / 2048.0f) + 1e-5f);
        if (lane == 0) { ST[2 * row] = mean; ST[2 * row + 1] = rstd; }
        const bool has_prev = (row % T_SEQ) != 0;
#pragma unroll
        for (int i = 0; i < 6; ++i) { const int c = lane + 64 * i; const float cur = bf1(PS[(size_t)row * PSW + 6144 + c]);
            const float prev = has_prev ? bf1(PS[(size_t)(row - 1) * PSW + 6144 + c]) : 0.f; const float m = p->mu[6144 + c];
            float val = cur + (prev - cur) * m;
            if (i == 0) val = 1.0f - 2.0f * __builtin_amdgcn_rcpf(1.0f + __expf(2.0f * val));
            else if (i >= 2) val = sigmoidf_(val);
            A2[(size_t)row * LK + c] = f2bf(val); }
    }
}

__device__ __forceinline__ void phase_gmlp(KP p, unsigned char* ldsg, int tid, int lane, int wave) {
    unsigned char* ws = p->wsb;
    const bf16_t* Z = (const bf16_t*)(ws + OFF_Z); const float* ST = (const float*)(ws + OFF_ST); bf16_t* Y = (bf16_t*)(ws + OFF_Y);
    LAS bf16_t* Wm = (LAS bf16_t*)(LAS unsigned char*)ldsg; LAS bf16_t* Vt = Wm + 128 * 136;
    const int fr = lane & 15, fq = lane >> 4;
    const int si = tid >> 2, sb = (tid & 3) * 32;
    f32x4 wreg[8], greg[8], breg[8]; u32x4 zreg[4]; float mean = 0.f, rstd = 0.f;
#define GM_LOAD(UNIT) do { const int h_ = (UNIT) & 15, tok_ = ((UNIT) >> 4) * 128 + si; \
        const f32x4* wsrc_ = (const f32x4*)(p->ws + ((size_t)h_ * 128 + si) * 128 + sb); const u32x4* zsrc_ = (const u32x4*)(Z + (size_t)tok_ * DM + 2048 + h_ * 128 + sb); \
        const f32x4* gsrc_ = (const f32x4*)(p->ln_g + h_ * 128 + sb); const f32x4* bsrc_ = (const f32x4*)(p->ln_b + h_ * 128 + sb); \
        _Pragma("unroll") for (int q_ = 0; q_ < 8; ++q_) { wreg[q_] = wsrc_[q_]; greg[q_] = gsrc_[q_]; breg[q_] = bsrc_[q_]; } \
        _Pragma("unroll") for (int q_ = 0; q_ < 4; ++q_) zreg[q_] = zsrc_[q_]; \
        mean = ST[2 * tok_]; rstd = ST[2 * tok_ + 1]; } while (0)
    int unit = blockIdx.x;
    if (unit < 2048) GM_LOAD(unit);
    for (; unit < 2048; unit += gridDim.x) {
        const int h = unit & 15, bn = unit >> 4, tok0 = bn * 128;
        { const bool keep = (sb >> 6) <= (si >> 6);
#pragma unroll
          for (int q = 0; q < 4; ++q) { f32x4 a = wreg[2 * q], b = wreg[2 * q + 1]; if (!keep) { a = (f32x4){0.f, 0.f, 0.f, 0.f}; b = a; }
              u32x4 o; o.x = pk2(a.x, a.y); o.y = pk2(a.z, a.w); o.z = pk2(b.x, b.y); o.w = pk2(b.z, b.w); *(LAS u32x4*)(Wm + si * 136 + sb + 8 * q) = o; } }
        {
#pragma unroll
          for (int q = 0; q < 4; ++q) { const u32x4 z8 = zreg[q]; const float zf[8] = {bflo(z8.x), bfhi(z8.x), bflo(z8.y), bfhi(z8.y), bflo(z8.z), bfhi(z8.z), bflo(z8.w), bfhi(z8.w)};
              const f32x4 g0 = greg[2 * q], g1 = greg[2 * q + 1], b0 = breg[2 * q], b1 = breg[2 * q + 1];
#pragma unroll
              for (int e = 0; e < 8; ++e) { const float gg = e < 4 ? g0[e & 3] : g1[e & 3], bb = e < 4 ? b0[e & 3] : b1[e & 3];
                  Vt[(sb + 8 * q + e) * 136 + si] = f2bf((zf[e] - mean) * rstd * gg + bb); } } }
        __syncthreads();
        const int nxt = unit + gridDim.x;
        if (nxt < 2048) GM_LOAD(nxt);
        const int i0 = 16 * wave; const int tok = tok0 + i0 + fr; const float bias = p->bs[h * 128 + i0 + fr];
        u32x2 ureg[8];
#pragma unroll
        for (int ct = 0; ct < 8; ++ct) ureg[ct] = *(const u32x2*)(Z + (size_t)tok * DM + h * 128 + ct * 16 + 4 * fq);
        f32x4 acc[8];
#pragma unroll
        for (int ct = 0; ct < 8; ++ct) acc[ct] = (f32x4){0.f, 0.f, 0.f, 0.f};
        const int nks = (wave < 4) ? 2 : 4;
        for (int ks = 0; ks < nks; ++ks) { const bf16x8 wf = *(const LAS bf16x8*)(Wm + (i0 + fr) * 136 + ks * 32 + fq * 8);
#pragma unroll
            for (int ct = 0; ct < 8; ++ct) { const bf16x8 vf = *(const LAS bf16x8*)(Vt + (ct * 16 + fr) * 136 + ks * 32 + fq * 8);
                acc[ct] = __builtin_amdgcn_mfma_f32_16x16x32_bf16(vf, wf, acc[ct], 0, 0, 0); } }
#pragma unroll
        for (int ct = 0; ct < 8; ++ct) { const int c = h * 128 + ct * 16 + 4 * fq; const u32x2 uu = ureg[ct];
            u32x2 o; o.x = pk2(bflo(uu.x) * (acc[ct][0] + bias), bfhi(uu.x) * (acc[ct][1] + bias)); o.y = pk2(bflo(uu.y) * (acc[ct][2] + bias), bfhi(uu.y) * (acc[ct][3] + bias));
            *(u32x2*)(Y + (size_t)tok * DM + c) = o; }
        __syncthreads();
    }
#undef GM_LOAD
}

constexpr int BG_O = (DM / 64) * (DM / 64), BG_1 = (DM / 64) * (FFD / 64), BG_2 = (FFD / 64) * (DM / 64), BG_ITEMS = BG_O + BG_1 + BG_2;
struct BgRegs { float v[16]; };
__device__ __forceinline__ void bg_locate(KP p, int item, const float*& W, bf16_t*& WT, int& K, int& N, int& k0, int& n0) {
    unsigned char* ws = p->wsb; int r = item;
    if (r < BG_O) { W = p->w_out; WT = (bf16_t*)(ws + OFF_WOT); K = DM; N = DM; }
    else { r -= BG_O; if (r < BG_1) { W = p->w_ff1; WT = (bf16_t*)(ws + OFF_W1T); K = DM; N = FFD; } else { r -= BG_1; W = p->w_ff2; WT = (bf16_t*)(ws + OFF_W2T); K = FFD; N = DM; } }
    const int lg = (N == DM) ? 6 : 8; k0 = (r >> lg) * 64; n0 = (r & ((1 << lg) - 1)) * 64;
}
__device__ __forceinline__ void bg_load(KP p, BgRegs& R, int item, int w4, int lane) {
    const float* W; bf16_t* WT; int K, N, k0, n0; bg_locate(p, item, W, WT, K, N, k0, n0);
    const __amdgpu_buffer_rsrc_t rs = __builtin_amdgcn_make_buffer_rsrc((void*)W, 0, 0x7fffffff, 0x00020000);
    const unsigned vo = (unsigned)lane * 4u, sbase = (unsigned)(((k0 + 16 * w4) * N + n0) * 4), rowb = (unsigned)N * 4u;
#pragma unroll
    for (int i = 0; i < 16; ++i) R.v[i] = __builtin_bit_cast(float, __builtin_amdgcn_raw_buffer_load_b32(rs, vo, sbase + (unsigned)i * rowb, 0));
}
__device__ __forceinline__ void bg_store(KP p, const BgRegs& R, int item, int w4, int lane) {
    const float* W; bf16_t* WT; int K, N, k0, n0; bg_locate(p, item, W, WT, K, N, k0, n0);
    u32x4 a, b; a.x = pk2(R.v[0], R.v[1]); a.y = pk2(R.v[2], R.v[3]); a.z = pk2(R.v[4], R.v[5]); a.w = pk2(R.v[6], R.v[7]);
    b.x = pk2(R.v[8], R.v[9]); b.y = pk2(R.v[10], R.v[11]); b.z = pk2(R.v[12], R.v[13]); b.w = pk2(R.v[14], R.v[15]);
    u32x4* dst = (u32x4*)(WT + (size_t)(n0 + lane) * K + k0 + 16 * w4); dst[0] = a; dst[1] = b;
}
constexpr int SC = 32;
constexpr int SBUF = 43008, L_WW = 8192, L_BB = 16384, L_KP = 24576, L_RR = 32768, L_VV = 40960, L_YP = 2 * SBUF, YPB = 32768;
static_assert(L_YP + 2 * YPB <= LDS_BYTES, "scan LDS");
struct ScanConst { float mur[8], muk[8], muv[8], kk_[8], ka[8], rk[8]; };
typedef _Float16 h8v __attribute__((ext_vector_type(8)));
struct ScanRaw { u32x4 rc, kc, vc, rp, kp_, vp; h8v e8, a8; };
__device__ __forceinline__ void scan_load(ScanRaw& R, const bf16_t* PS, const _Float16* LO, size_t tok, bool hasp, int hc) {
    const bf16_t* row = PS + tok * PSW + hc; const bf16_t* prow = row - PSW;
    const u32x4 zero = {0u, 0u, 0u, 0u};
    R.rc = *(const u32x4*)(row); R.kc = *(const u32x4*)(row + 2048); R.vc = *(const u32x4*)(row + 4096);
    R.rp = hasp ? *(const u32x4*)(prow) : zero; R.kp_ = hasp ? *(const u32x4*)(prow + 2048) : zero; R.vp = hasp ? *(const u32x4*)(prow + 4096) : zero;
    R.e8 = *(const h8v*)(LO + tok * LN_ + hc); R.a8 = *(const h8v*)(LO + tok * LN_ + 2048 + hc);
}
typedef __amdgpu_buffer_rsrc_t bufrsrc_t;
__device__ __forceinline__ bufrsrc_t make_rsrc(const void* p) { return __builtin_amdgcn_make_buffer_rsrc((void*)p, 0, 0x7fffffff, 0x00020000); }
struct ScanOff { unsigned r, k, v, e, a; };
__device__ __forceinline__ void scan_load_buf(ScanRaw& R, bufrsrc_t rsP, bufrsrc_t rsL, const ScanOff& o, unsigned soffP, unsigned soffL) {
    R.rc = __builtin_amdgcn_raw_buffer_load_b128(rsP, o.r, soffP, 0); R.kc = __builtin_amdgcn_raw_buffer_load_b128(rsP, o.k, soffP, 0); R.vc = __builtin_amdgcn_raw_buffer_load_b128(rsP, o.v, soffP, 0);
    const unsigned soffPp = soffP - (unsigned)(PSW * 2);
    R.rp = __builtin_amdgcn_raw_buffer_load_b128(rsP, o.r, soffPp, 0); R.kp_ = __builtin_amdgcn_raw_buffer_load_b128(rsP, o.k, soffPp, 0); R.vp = __builtin_amdgcn_raw_buffer_load_b128(rsP, o.v, soffPp, 0);
    R.e8 = __builtin_bit_cast(h8v, __builtin_amdgcn_raw_buffer_load_b128(rsL, o.e, soffL, 0)); R.a8 = __builtin_bit_cast(h8v, __builtin_amdgcn_raw_buffer_load_b128(rsL, o.a, soffL, 0));
}
__device__ __forceinline__ void scan_prep(LAS unsigned char* buf, const ScanConst& C, const ScanRaw& R, int pt, int kb, int q, float* bon) {
    const u32x4 rc = R.rc, kc = R.kc, vc = R.vc, rp = R.rp, kp_ = R.kp_, vp = R.vp; const h8v e8 = R.e8, a8 = R.a8;
    float r[8], k[8], v[8], a[8], kk[8], wv[8], kq[8]; float ss = 0.f;
    const unsigned rcw[4] = {rc.x, rc.y, rc.z, rc.w}, rpw[4] = {rp.x, rp.y, rp.z, rp.w}, kcw[4] = {kc.x, kc.y, kc.z, kc.w}, kpw[4] = {kp_.x, kp_.y, kp_.z, kp_.w};
    const unsigned vcw[4] = {vc.x, vc.y, vc.z, vc.w}, vpw[4] = {vp.x, vp.y, vp.z, vp.w};
#pragma unroll
    for (int e = 0; e < 8; ++e) { const int wq = e >> 1; const bool hi = e & 1;
        const float rcf = hi ? bfhi(rcw[wq]) : bflo(rcw[wq]), rpf = hi ? bfhi(rpw[wq]) : bflo(rpw[wq]);
        const float kcf = hi ? bfhi(kcw[wq]) : bflo(kcw[wq]), kpf = hi ? bfhi(kpw[wq]) : bflo(kpw[wq]);
        const float vcf = hi ? bfhi(vcw[wq]) : bflo(vcw[wq]), vpf = hi ? bfhi(vpw[wq]) : bflo(vpw[wq]);
        r[e] = rcf + (rpf - rcf) * C.mur[e]; k[e] = kcf + (kpf - kcf) * C.muk[e]; v[e] = vcf + (vpf - vcf) * C.muv[e];
        a[e] = (float)a8[e];
        wv[e] = __expf(-(float)e8[e]);
        kk[e] = k[e] * C.kk_[e]; ss += kk[e] * kk[e];
        kq[e] = k[e] * (1.0f + (a[e] - 1.0f) * C.ka[e]); }
    { float bs = 0.f;
#pragma unroll
      for (int e = 0; e < 8; ++e) bs += r[e] * kq[e] * C.rk[e];
      bs += dpp_mov<0xB1>(bs); bs += dpp_mov<0x4E>(bs); bs += dpp_mov<0x141>(bs);
      if (bon) *bon = bs; }
    ss += dpp_mov<0xB1>(ss); ss += dpp_mov<0x4E>(ss); ss += dpp_mov<0x141>(ss);
    const float inv = __builtin_amdgcn_rsqf(fmaxf(ss, 1e-24f));
#pragma unroll
    for (int e = 0; e < 8; ++e) kk[e] *= inv;
    LAS f32x4* d = (LAS f32x4*)(buf + pt * 256 + kb * 4);
    d[0] = (f32x4){kk[0], kk[1], kk[2], kk[3]}; d[1] = (f32x4){kk[4], kk[5], kk[6], kk[7]};
    d[L_WW / 16] = (f32x4){wv[0], wv[1], wv[2], wv[3]}; d[L_WW / 16 + 1] = (f32x4){wv[4], wv[5], wv[6], wv[7]};
    d[L_BB / 16] = (f32x4){kk[0] * a[0], kk[1] * a[1], kk[2] * a[2], kk[3] * a[3]}; d[L_BB / 16 + 1] = (f32x4){kk[4] * a[4], kk[5] * a[5], kk[6] * a[6], kk[7] * a[7]};
    d[L_KP / 16] = (f32x4){kq[0], kq[1], kq[2], kq[3]}; d[L_KP / 16 + 1] = (f32x4){kq[4], kq[5], kq[6], kq[7]};
    d[L_RR / 16] = (f32x4){r[0], r[1], r[2], r[3]}; d[L_RR / 16 + 1] = (f32x4){r[4], r[5], r[6], r[7]};
    if ((kb >> 4) == q) { LAS float* dv = (LAS float*)(buf + L_VV) + (kb & 15) * SC + pt;
#pragma unroll
        for (int e = 0; e < 8; ++e) dv[e * SC] = v[e]; }
}
__device__ __forceinline__ void scan_yreduce(const LAS unsigned char* ypb, float* YR, size_t tokbase, int colbase, int tid2) {
#pragma unroll
    for (int i = 0; i < 2; ++i) { const int o = tid2 + 256 * i, t = o >> 4, rw = o & 15;
        const LAS f32x4* s4 = (const LAS f32x4*)(ypb + (size_t)o * 64);
        const f32x4 a = s4[0], b = s4[1], c = s4[2], d = s4[3];
        const f32x4 z = (a + b) + (c + d);
        YR[(tokbase + t) * RW + colbase + rw] = (z.x + z.y) + (z.z + z.w); }
}
__device__ __forceinline__ void scan_consume(f32x4& S, const LAS unsigned char* buf, LAS unsigned char* ypb, int j, int rl, int wave, int lane) {
    const LAS f32x4* base = (const LAS f32x4*)(buf) + j;
    const LAS f32x4* vb4 = (const LAS f32x4*)(buf + L_VV) + rl * (SC / 4);
    LAS float* yp = (LAS float*)(ypb) + wave * 64 + lane;
    f32x4 kkq[3], wq[3], bq[3], kq[3], rq[3]; f32x4 vq4[2];
#pragma unroll
    for (int u = 0; u < 2; ++u) { kkq[u] = base[u * 16]; wq[u] = base[L_WW / 16 + u * 16]; bq[u] = base[L_BB / 16 + u * 16]; kq[u] = base[L_KP / 16 + u * 16]; rq[u] = base[L_RR / 16 + u * 16]; }
    vq4[0] = vb4[0];
#pragma unroll
    for (int t = 0; t < SC; ++t) {
        const int tn = (t + 2 < SC) ? t + 2 : SC - 1; const int sl = (t + 2) % 3, cu = t % 3;
        kkq[sl] = base[tn * 16]; wq[sl] = base[L_WW / 16 + tn * 16]; bq[sl] = base[L_BB / 16 + tn * 16]; kq[sl] = base[L_KP / 16 + tn * 16]; rq[sl] = base[L_RR / 16 + tn * 16];
        if ((t & 3) == 0 && t + 4 < SC) vq4[((t >> 2) + 1) & 1] = vb4[(t >> 2) + 1];
        const f32x4 kk4 = kkq[cu], w4 = wq[cu], b4 = bq[cu], k4 = kq[cu], r4 = rq[cu]; const float vv = vq4[(t >> 2) & 1][t & 3];
        float sa = fmaf(S.w, kk4.w, fmaf(S.z, kk4.z, fmaf(S.y, kk4.y, S.x * kk4.x)));
        const f32x4 vk = vv * k4;
        sa = -red16(sa);
        S = S * w4 + (sa * b4 + vk);
        yp[t * 256] = fmaf(S.w, r4.w, fmaf(S.z, r4.z, fmaf(S.y, r4.y, S.x * r4.x)));
    }
}
#define SCAN_BAR() do { asm volatile("s_waitcnt lgkmcnt(0)" ::: "memory"); __builtin_amdgcn_s_barrier(); asm volatile("" ::: "memory"); } while (0)
__device__ __forceinline__ void phase_scan(KP p, unsigned char* ldsg, int tid, int lane, int wave) {
    unsigned char* ws = p->wsb;
    const bf16_t* PS = (const bf16_t*)(ws + OFF_PS); const _Float16* LO = (const _Float16*)(ws + OFF_LO); float* YR = (float*)(ws + OFF_YRAW);
    LAS unsigned char* lds = (LAS unsigned char*)ldsg;
    const int G = gridDim.x, bx = blockIdx.x; const int vcu = (G % 8 == 0) ? (bx % 8) * (G / 8) + bx / 8 : bx;
    constexpr int NCH = T_SEQ / SC;
    int iter = 0;
    for (int su = vcu; su < 256; su += G, ++iter) {
        const int hp = su >> 2, q = su & 3, b = hp >> 5, h = hp & 31;
        const size_t tokb = (size_t)b * T_SEQ; const int colbase = h * 64 + q * 16;
#ifdef PROBE_ISO
        { f32x4 Sp = {0.f, 0.f, 0.f, 0.f};
          if (wave < 4) { for (int c = 0; c < PROBE_ISO; ++c) { scan_consume(Sp, lds, lds + L_YP, lane & 15, wave * 4 + (lane >> 4), wave, lane); asm volatile("" ::: "memory"); }
              if (Sp.x == 1.2345e-30f) YR[0] = Sp.y; }
          __syncthreads(); }
#endif
        if (wave >= 4) {
            const int tid2 = tid - 256, pt = tid2 >> 3, kb = (tid2 & 7) * 8, hc = h * 64 + kb;
            ScanConst C;
#pragma unroll
            for (int e = 0; e < 8; ++e) { C.mur[e] = p->mu[hc + e]; C.muk[e] = p->mu[2048 + hc + e]; C.muv[e] = p->mu[4096 + hc + e]; C.kk_[e] = p->k_k[hc + e]; C.ka[e] = p->k_a[hc + e]; C.rk[e] = p->r_k[hc + e]; }
            ScanRaw A, B;
            ScanOff so; so.r = (unsigned)(pt * PSW + hc) * 2u; so.k = so.r + 4096u; so.v = so.r + 8192u; so.e = (unsigned)(pt * LN_ + hc) * 2u; so.a = so.e + 4096u;
            const bufrsrc_t rsP = make_rsrc(PS), rsL = make_rsrc(LO);
            const unsigned pbase = (unsigned)(tokb * PSW * 2), lbase = (unsigned)(tokb * LN_ * 2);
            scan_load(A, PS, LO, tokb + pt, pt > 0, hc);
            float* const BON = (float*)(ws + OFF_BON); const bool bw = (q == 0) && (kb == 0);
            scan_prep(lds, C, A, pt, kb, q, bw ? BON + (tokb + pt) * 32 + h : nullptr);
            scan_load(A, PS, LO, tokb + SC + pt, true, hc);
            const int w4 = wave - 4; BgRegs BG; int bg_cur = -1;
            int bg_next = (iter * NCH) * G + bx;
            SCAN_BAR();
            for (int c = 0; c < NCH; ++c) {
                if (c + 1 < NCH) { B = A;
                    if (c + 2 < NCH) scan_load_buf(A, rsP, rsL, so, pbase + (unsigned)(c + 2) * (unsigned)(SC * PSW * 2), lbase + (unsigned)(c + 2) * (unsigned)(SC * LN_ * 2));
                    scan_prep(lds + ((c + 1) & 1) * SBUF, C, B, pt, kb, q, bw ? BON + (tokb + (size_t)(c + 1) * SC + pt) * 32 + h : nullptr); }
                if (c >= 1) scan_yreduce(lds + L_YP + ((c - 1) & 1) * YPB, YR, tokb + (size_t)(c - 1) * SC, colbase, tid2);
                if (bg_cur >= 0) { bg_store(p, BG, bg_cur, w4, lane); bg_cur = -1; }
                if (bg_next < BG_ITEMS) { bg_load(p, BG, bg_next, w4, lane); bg_cur = bg_next; }
                bg_next += G;
                SCAN_BAR();
            }
            if (bg_cur >= 0) bg_store(p, BG, bg_cur, w4, lane);
            scan_yreduce(lds + L_YP + ((NCH - 1) & 1) * YPB, YR, tokb + (size_t)(NCH - 1) * SC, colbase, tid2);
        } else {
            const int j = lane & 15, rl = wave * 4 + (lane >> 4);
            f32x4 S = {0.f, 0.f, 0.f, 0.f};
            __builtin_amdgcn_s_setprio(3);
            SCAN_BAR();
            for (int c = 0; c < NCH; ++c) {
                scan_consume(S, lds + (c & 1) * SBUF, lds + L_YP + (c & 1) * YPB, j, rl, wave, lane);
                SCAN_BAR();
            }
            __builtin_amdgcn_s_setprio(0);
        }
        __syncthreads();
    }
    if (wave >= 4) { BgRegs BG; for (int item = (iter * NCH) * G + bx; item < BG_ITEMS; item += G) { bg_load(p, BG, item, wave - 4, lane); bg_store(p, BG, item, wave - 4, lane); } }
}

__device__ __forceinline__ void phase_post(KP p, int gw, int NGW, int lane) {
    unsigned char* ws = p->wsb;
    const bf16_t* PS = (const bf16_t*)(ws + OFF_PS); const _Float16* LO = (const _Float16*)(ws + OFF_LO); const float* YR = (const float*)(ws + OFF_YRAW); const float* BON = (const float*)(ws + OFF_BON); bf16_t* Y = (bf16_t*)(ws + OFF_Y);
    for (int tok = gw; tok < M_TOK; tok += NGW) {
        const bool hasp = (tok % T_SEQ) != 0;
        const bf16_t* row = PS + (size_t)tok * PSW; const bf16_t* prow = row - PSW;
#pragma unroll 2
        for (int hg = 0; hg < 8; ++hg) { const int col = hg * 256 + lane * 4;
            const f32x4 y = *(const f32x4*)(YR + (size_t)tok * RW + col);
            const u32x2 z2 = {0u, 0u};
            const u32x2 vc = *(const u32x2*)(row + 4096 + col);
            const u32x2 vp = hasp ? *(const u32x2*)(prow + 4096 + col) : z2;
            const f32x4 muv = *(const f32x4*)(p->mu + 4096 + col);
            typedef _Float16 h4 __attribute__((ext_vector_type(4))); const h4 g2 = *(const h4*)(LO + (size_t)tok * LN_ + 4096 + col);
            const f32x4 lg = *(const f32x4*)(p->lnx_g + col), lb = *(const f32x4*)(p->lnx_b + col);
            const float bonus = BON[(size_t)tok * 32 + hg * 4 + (lane >> 4)];
            const f32x4 vcf = {bflo(vc.x), bfhi(vc.x), bflo(vc.y), bfhi(vc.y)}, vpf = {bflo(vp.x), bfhi(vp.x), bflo(vp.y), bfhi(vp.y)};
            const f32x4 gf = {(float)g2[0], (float)g2[1], (float)g2[2], (float)g2[3]};
            const f32x4 v = vcf + (vpf - vcf) * muv;
            const float mean = red16((y.x + y.y) + (y.z + y.w)) * (1.0f / 64.0f);
            const f32x4 d = y - mean;
            const float var = red16((d.x * d.x + d.y * d.y) + (d.z * d.z + d.w * d.w)) * (1.0f / 64.0f);
            const float rstd = rsqrtf(var + 64e-5f);
            const f32x4 o = ((d * rstd) * lg + lb + bonus * v) * gf;
            u32x2 w; w.x = pk2(o.x, o.y); w.y = pk2(o.z, o.w);
            *(u32x2*)(Y + (size_t)tok * DM + 2048 + col) = w; }
    }
}

__device__ __forceinline__ void phase7(KP p, int gw, int NGW, int lane) {
    unsigned char* ws = p->wsb;
    const bf16_t* MIX = (const bf16_t*)(ws + OFF_MIX); const float* SS = (const float*)(ws + OFF_SS1); bf16_t* H = (bf16_t*)(ws + OFF_H);
    for (int row = gw; row < M_TOK; row += NGW) {
        const float* gp1 = p->post_mix_g; const float* gp2 = p->pre_ffn_g; asm volatile("" : "+s"(gp1), "+s"(gp2));
        const float rs1 = rsqrtf(wave_sum(SS[(size_t)row * 64 + lane]) * (1.0f / DM) + 1e-6f);
        const f32x4* xr = (const f32x4*)(p->x + (size_t)row * DM) + lane; const u32x2* mr = (const u32x2*)(MIX + (size_t)row * DM) + lane;
        u32x2* x1row = (u32x2*)(p->out + (size_t)row * DM) + lane; u32x2* hrow = (u32x2*)(H + (size_t)row * DM) + lane;
        f32x4 v[16]; float s = 0.f;
#pragma unroll
        for (int jh = 0; jh < 4; ++jh) {
            const f32x4* xg = xr + 256 * jh; const u32x2* mg = mr + 256 * jh; const f32x4* gg1 = (const f32x4*)gp1 + lane + 256 * jh; asm volatile("" : "+v"(xg), "+v"(mg), "+v"(gg1));
#pragma unroll
            for (int jj = 0; jj < 4; ++jj) { const int j = jh * 4 + jj; const f32x4 xx = xg[64 * jj]; const u32x2 mm = mg[64 * jj]; const f32x4 g = gg1[64 * jj];
                const f32x4 mf = {bflo(mm.x), bfhi(mm.x), bflo(mm.y), bfhi(mm.y)};
                v[j] = xx + (mf * rs1) * g; s += (v[j].x * v[j].x + v[j].y * v[j].y) + (v[j].z * v[j].z + v[j].w * v[j].w); }
            asm volatile("" ::: "memory"); }
        const float rs2 = rsqrtf(wave_sum(s) * (1.0f / DM) + 1e-6f);
#pragma unroll
        for (int jh = 0; jh < 4; ++jh) {
            u32x2* x1g = x1row + 256 * jh; u32x2* hg = hrow + 256 * jh; const f32x4* gg2 = (const f32x4*)gp2 + lane + 256 * jh; asm volatile("" : "+v"(x1g), "+v"(hg), "+v"(gg2));
#pragma unroll
            for (int jj = 0; jj < 4; ++jj) { const int j = jh * 4 + jj; const f32x4 g = gg2[64 * jj];
                u32x2 w; w.x = pk2(v[j].x, v[j].y); w.y = pk2(v[j].z, v[j].w); x1g[64 * jj] = w;
                u32x2 h; h.x = pk2(v[j].x * rs2 * g.x, v[j].y * rs2 * g.y); h.y = pk2(v[j].z * rs2 * g.z, v[j].w * rs2 * g.w); hg[64 * jj] = h; }
            asm volatile("" ::: "memory"); }
    }
}
__device__ __forceinline__ void phase10(KP p, int gw, int NGW, int lane) {
    unsigned char* ws = p->wsb;
    const bf16_t* F = (const bf16_t*)(ws + OFF_F); const float* SS = (const float*)(ws + OFF_SS2);
    for (int row = gw; row < M_TOK; row += NGW) {
        const float* gp3 = p->post_ffn_g; asm volatile("" : "+s"(gp3));
        const float rs = rsqrtf(wave_sum(SS[(size_t)row * 64 + lane]) * (1.0f / DM) + 1e-6f);
        f32x4* orow = (f32x4*)(p->out + (size_t)row * DM) + lane; const u32x2* x1row = (const u32x2*)(p->out + (size_t)row * DM) + lane; const u32x2* fr_ = (const u32x2*)(F + (size_t)row * DM) + lane;
        u32x2 xb[16], fb[16];
#pragma unroll
        for (int j = 0; j < 16; ++j) { xb[j] = x1row[64 * j]; fb[j] = fr_[64 * j]; }
        asm volatile("s_waitcnt vmcnt(0)" ::: "memory");
#pragma unroll
        for (int j = 0; j < 16; ++j) { const f32x4 g = ((const f32x4*)gp3)[lane + 64 * j];
            const f32x4 xx = {bflo(xb[j].x), bfhi(xb[j].x), bflo(xb[j].y), bfhi(xb[j].y)}, mf = {bflo(fb[j].x), bfhi(fb[j].x), bflo(fb[j].y), bfhi(fb[j].y)};
            orow[64 * j] = xx + (mf * rs) * g; }
    }
}

constexpr int NPHASE = 11;
__global__ void __launch_bounds__(NTHREADS, 2) fwd_megakernel(Params p_) {
    extern __shared__ __attribute__((aligned(16))) unsigned char lds[];
    const int tid = threadIdx.x, lane = tid & 63, wave = __builtin_amdgcn_readfirstlane(tid >> 6);
    const int G = gridDim.x, gw = blockIdx.x * NWAVES + wave, NGW = G * NWAVES;
    const int lo = p_.ph_lo, hi = p_.ph_hi;
    volatile LAS unsigned* xst = (volatile LAS unsigned*)((LAS unsigned char*)lds + (LDS_BYTES - 16));
    XcdBarrier xbar; xbar.bar = nullptr; xbar.x = 0; xbar.st = xst;
    if (p_.coop) { if (tid == 0) { xst[0] = 0u; xst[1] = 0u; } __syncthreads(); xbar = xcd_barrier_post((unsigned*)(p_.wsb + OFF_BAR), xst); }
    if (p_.coop == 2) cg::this_grid().sync();
#define GRIDBAR() xcd_barrier(xbar)
#ifndef PH_MASK
#define PH_MASK 0x7ff
#endif
#define IN(k) ((((PH_MASK) >> (k)) & 1) && lo <= (k) && (k) < hi)
#define SEAM(k) do { if (IN(k) && IN((k) + 1)) { GRIDBAR(); } } while (0)
#ifndef REPEAT_MASK
#define REPEAT_MASK 0
#endif
#define REPS(k) ((((REPEAT_MASK) >> (k)) & 1) ? 2 : 1)
#define RSYNC(k, r) do { if ((r) + 1 < REPS(k)) GRIDBAR(); } while (0)
    if (IN(0)) { for (int rep = 0; rep < REPS(0); ++rep) { KP p = kparams(); phase0(p, lds, gw, NGW, lane, wave); RSYNC(0, rep); } } SEAM(0);
    if (IN(1)) for (int rep = 0; rep < REPS(1); ++rep) { KP p = kparams(); unsigned char* ws = p->wsb; pg8::Gemm g{(const bf16_t*)(ws + OFF_H), (const bf16_t*)(ws + OFF_WIN), M_TOK, NPAD, DM}; pg8::StaticOrder S; S.init(M_TOK, NPAD, G, (int)blockIdx.x);
        EpiProj E{(bf16_t*)(ws + OFF_Z), (bf16_t*)(ws + OFF_PS)};
        pg8::gemm_phase<EpiProj, pg8::StaticOrder>((PG8_LAS unsigned char*)lds, g, S, E, nullptr); RSYNC(1, rep); } SEAM(1);
    if (IN(2)) { for (int rep = 0; rep < REPS(2); ++rep) { KP p = kparams(); phase2(p, gw, NGW, lane); RSYNC(2, rep); } } SEAM(2);
    if (IN(3)) for (int rep = 0; rep < REPS(3); ++rep) { KP p = kparams(); unsigned char* ws = p->wsb; { pg8::Gemm g{(const bf16_t*)(ws + OFF_A2), (const bf16_t*)(ws + OFF_BT2), M_TOK, LN_, LK}; pg8::StaticOrder S; S.init(M_TOK, LN_, G, (int)blockIdx.x);
          EpiF16 E{(unsigned short*)(ws + OFF_LO), p->w0, p->a0};
          pg8::gemm_phase<EpiF16, pg8::StaticOrder>((PG8_LAS unsigned char*)lds, g, S, E, nullptr); }
        __syncthreads();
        phase_gmlp(p, lds, tid, lane, wave); RSYNC(3, rep); } SEAM(3);
    if (IN(4)) { for (int rep = 0; rep < REPS(4); ++rep) { KP p = kparams(); phase_scan(p, lds, tid, lane, wave); RSYNC(4, rep); } } SEAM(4);
    if (IN(5)) { for (int rep = 0; rep < REPS(5); ++rep) { KP p = kparams(); phase_post(p, gw, NGW, lane); RSYNC(5, rep); } } SEAM(5);
    if (IN(6)) for (int rep = 0; rep < REPS(6); ++rep) { KP p = kparams(); unsigned char* ws = p->wsb; pg8::Gemm g{(const bf16_t*)(ws + OFF_Y), (const bf16_t*)(ws + OFF_WOT), M_TOK, DM, DM}; pg8::StaticOrder S; S.init(M_TOK, DM, G, (int)blockIdx.x);
        EpiNormPart E{(bf16_t*)(ws + OFF_MIX), (float*)(ws + OFF_SS1)};
        pg8::gemm_phase<EpiNormPart, pg8::StaticOrder>((PG8_LAS unsigned char*)lds, g, S, E, nullptr); RSYNC(6, rep); } SEAM(6);
    if (IN(7)) { for (int rep = 0; rep < REPS(7); ++rep) { KP p = kparams(); phase7(p, gw, NGW, lane); RSYNC(7, rep); } } SEAM(7);
    if (IN(8)) for (int rep = 0; rep < REPS(8); ++rep) { KP p = kparams(); unsigned char* ws = p->wsb; pg8::Gemm g{(const bf16_t*)(ws + OFF_H), (const bf16_t*)(ws + OFF_W1T), M_TOK, FFD, DM}; pg8::StaticOrder S; S.init(M_TOK, FFD, G, (int)blockIdx.x);
        EpiRelu2 E{(bf16_t*)(ws + OFF_HID)};
        pg8::gemm_phase<EpiRelu2, pg8::StaticOrder>((PG8_LAS unsigned char*)lds, g, S, E, nullptr); RSYNC(8, rep); } SEAM(8);
    if (IN(9)) for (int rep = 0; rep < REPS(9); ++rep) { KP p = kparams(); unsigned char* ws = p->wsb; pg8::Gemm g{(const bf16_t*)(ws + OFF_HID), (const bf16_t*)(ws + OFF_W2T), M_TOK, DM, FFD}; pg8::StaticOrder S; S.init(M_TOK, DM, G, (int)blockIdx.x);
        EpiNormPart E{(bf16_t*)(ws + OFF_F), (float*)(ws + OFF_SS2)};
        pg8::gemm_phase<EpiNormPart, pg8::StaticOrder>((PG8_LAS unsigned char*)lds, g, S, E, nullptr); RSYNC(9, rep); } SEAM(9);
    if (IN(10)) { KP p = kparams(); phase10(p, gw, NGW, lane); }
#undef IN
#undef SEAM
}

#ifndef N_LAUNCH_MODE
#define N_LAUNCH_MODE 1
#endif
extern "C" void kernel_launch(void* const* d_in, const int* in_sizes, int n_in, void* d_out, int out_size, void* d_ws, size_t ws_size, hipStream_t stream) {
    static int grid = 0;
    if (grid == 0) {
        int dev = 0, cus = 0, per_cu = 0;
        (void)hipGetDevice(&dev); (void)hipDeviceGetAttribute(&cus, hipDeviceAttributeMultiprocessorCount, dev);
        if (hipFuncSetAttribute((const void*)fwd_megakernel, hipFuncAttributeMaxDynamicSharedMemorySize, LDS_BYTES) != hipSuccess) fprintf(stderr, "hipFuncSetAttribute failed\n");
        if (hipOccupancyMaxActiveBlocksPerMultiprocessor(&per_cu, (const void*)fwd_megakernel, NTHREADS, LDS_BYTES) != hipSuccess || per_cu < 1) { fprintf(stderr, "occupancy query: %d\n", per_cu); per_cu = 1; }
        (void)hipGetLastError();
        grid = cus * 1;
        if (n_in != 24 || ws_size < WS_END) fprintf(stderr, "unexpected n_in %d / ws_size %zu (need %zu)\n", n_in, ws_size, (size_t)WS_END);
    }
    Params p{};
    const float** pp = (const float**)&p;
    for (int i = 0; i < 24; ++i) pp[i] = (const float*)d_in[i];
    p.out = (float*)d_out; p.wsb = (unsigned char*)d_ws; p.pad = 0;
#if N_LAUNCH_MODE == 1
    p.ph_lo = 0; p.ph_hi = NPHASE; p.coop = 1;
    (void)hipMemsetAsync((unsigned char*)d_ws + OFF_BAR, 0, 16384, stream);
    void* args[] = {&p};
    hipError_t e = hipLaunchCooperativeKernel((const void*)fwd_megakernel, dim3(grid), dim3(NTHREADS), args, LDS_BYTES, stream);
    if (e != hipSuccess) fprintf(stderr, "cooperative launch failed: %s (grid %d)\n", hipGetErrorString(e), grid);
#else
    for (int ph = 0; ph < NPHASE; ++ph) { p.ph_lo = ph; p.ph_hi = ph + 1; p.coop = 0;
        hipLaunchKernelGGL(fwd_megakernel, dim3(grid), dim3(NTHREADS), LDS_BYTES, stream, p); }
#endif
}
```

```cpp
#include <hip/hip_runtime.h>
#include <hip/hip_cooperative_groups.h>
#include <cstdio>
namespace cg = cooperative_groups;
namespace pg8 {
#define PG8_LAS __attribute__((address_space(3)))
typedef unsigned short bf16_t;
typedef short bf16x8 __attribute__((ext_vector_type(8)));
typedef float f32x4 __attribute__((ext_vector_type(4)));
typedef unsigned u32x4 __attribute__((ext_vector_type(4)));
constexpr int BM = 256, BK = 64, HALF = 128, HTB = HALF * BK * 2  , STAGE_BYTES = 8 * HTB, NXCD = 8, WGM = 8;

__host__ __device__ __forceinline__ int lds_byte(int r, int c) { const int st = (r >> 4) * 2 + (c >> 5), rr = r & 15, cc = c & 31, ob = rr * 64 + cc * 2; return st * 1024 + (ob ^ (((ob >> 9) & 1) << 5)); }
__host__ __device__ __forceinline__ void stage_rc(int b, int& R, int& C) { const int st = b / 1024, sb = b % 1024, swz = sb ^ (((sb >> 9) & 1) << 5); R = (st >> 1) * 16 + swz / 64; C = (st & 1) * 32 + (swz % 64) / 2; }
__host__ __device__ __forceinline__ int perm32(int rho) { const int n = rho >> 4, i = rho & 15; return 8 * (i >> 2) + 4 * n + (i & 3); }

struct Unit { int pm, pn, ko; };
struct Gemm { const bf16_t* A; const bf16_t* Bt; int M, N, K, ld; };

struct StaticOrder {
    int nM, nN, nwg, G, c, ko;
    __host__ __device__ void init(int M, int N, int G_, int c_, int ko_ = 0) { nM = M / BM; nN = N / BM; nwg = nM * nN; G = G_; c = c_; ko = ko_; }
    __host__ __device__ bool next(int i, Unit& u) const {
        const long L = (long)i * G + c; if (L >= nwg) return false;
        int wgid = (int)L; { const int q = nwg / NXCD, r = nwg % NXCD, xcd = wgid % NXCD, off = wgid / NXCD; wgid = (xcd < r ? xcd * (q + 1) : r * (q + 1) + (xcd - r) * q) + off; }
        const int nig = WGM * nN, gid = wgid / nig, fm = gid * WGM, gsz = (nM - fm) < WGM ? (nM - fm) : WGM;
        u.pm = fm + ((wgid % nig) % gsz); u.pn = (wgid % nig) / gsz; u.ko = ko; return true;
    }
    __device__ __forceinline__ void a_ready(const Unit&) const {}
    __device__ __forceinline__ void done(const Unit&) const {}
};
__device__ __forceinline__ unsigned cvt_pk_bf16(float lo, float hi) { unsigned r; asm volatile("v_cvt_pk_bf16_f32 %0, %1, %2" : "=v"(r) : "v"(lo), "v"(hi)); return r; }
typedef float f32x2 __attribute__((ext_vector_type(2)));
template <class Epi, class Sched, bool STAMP = false>
__device__ __forceinline__ void gemm_phase(PG8_LAS unsigned char* lds, const Gemm g, const Sched& S, const Epi& E, unsigned long long* stamps) {
    const int tid = threadIdx.x, wid = __builtin_amdgcn_readfirstlane(tid >> 6), lane = tid & 63, wr = wid >> 2, wc = wid & 3, fr = lane & 15, fq = lane >> 4;
    const int K = g.K, nt = K / BK;
    int ts_lo = 0, ts_hi = 0, nts = 0; const unsigned long long rt_entry = STAMP ? (unsigned long long)wall_clock64() : 0ull;
#define PG8_STAMP() do { if (STAMP && wid == 0 && nts < 64) { const unsigned long long _c = (unsigned long long)clock64(); \
        ts_lo = (lane == nts) ? (int)(unsigned)_c : ts_lo; ts_hi = (lane == nts) ? (int)(unsigned)(_c >> 32) : ts_hi; ++nts; } } while (0)
    PG8_STAMP();
    unsigned voffA[2], voffB[2];
#pragma unroll
    for (int i = 0; i < 2; ++i) { int R, C; stage_rc(tid * 16 + i * 8192, R, C); const int Rb = Epi::PERM ? ((R & ~31) + perm32(R & 31)) : R;
        voffA[i] = (unsigned)(R * g.ld + C) * 2u; voffB[i] = (unsigned)(Rb * g.ld + C) * 2u; }
    const size_t kstep = (size_t)(BK * 2);
    const size_t hstep = (size_t)HALF * g.ld * 2;
    const size_t tstep = 2 * hstep;
    const unsigned ldsw = (unsigned)wid * 1024u;
    const int aoff = lds_byte(wr * 64 + fr, fq * 8), boff = lds_byte(wc * 32 + fr, fq * 8);
#define PG8_SA(b, h) (((b) * 2 + (h)) * HTB)
#define PG8_SB(b, h) ((4 + (b) * 2 + (h)) * HTB)
#define PG8_STAGE(bufoff, gbase, voff) do { _Pragma("unroll") for (int _i = 0; _i < 2; ++_i) \
        __builtin_amdgcn_global_load_lds((const unsigned*)((const char*)(gbase) + (voff)[_i]), (PG8_LAS unsigned*)(lds + (bufoff) + ldsw + _i * 8192), 16, 0, 0); } while (0)
#define PG8_LDA(dst, b, h) do { _Pragma("unroll") for (int m = 0; m < 4; ++m) _Pragma("unroll") for (int k = 0; k < 2; ++k) dst[m][k] = *(const PG8_LAS bf16x8*)(lds + PG8_SA(b, h) + aoff + m * 2048 + k * 1024); } while (0)
#define PG8_LDB(dst, b, h) do { _Pragma("unroll") for (int n = 0; n < 2; ++n) _Pragma("unroll") for (int k = 0; k < 2; ++k) dst[n][k] = *(const PG8_LAS bf16x8*)(lds + PG8_SB(b, h) + boff + n * 2048 + k * 1024); } while (0)
#define PG8_MMA(ai, bj, At, Bt) do { __builtin_amdgcn_s_setprio(1); _Pragma("unroll") for (int m = 0; m < 4; ++m) _Pragma("unroll") for (int n = 0; n < 2; ++n) _Pragma("unroll") for (int k = 0; k < 2; ++k) \
        acc[ai][bj][m][n] = __builtin_amdgcn_mfma_f32_16x16x32_bf16(Bt[n][k], At[m][k], acc[ai][bj][m][n], 0, 0, 0); __builtin_amdgcn_s_setprio(0); } while (0)
#define PG8_WAIT_V(n) asm volatile("s_waitcnt vmcnt(" #n ")" ::: "memory")
#define PG8_WAIT_L(n) asm volatile("s_waitcnt lgkmcnt(" #n ")" ::: "memory")
#define PG8_BAR __builtin_amdgcn_s_barrier()
#define PG8_SCHED __builtin_amdgcn_sched_barrier(0)
    Unit cur, nxt; int ui = 0;
    if (!S.next(0, cur)) return;
    f32x4 acc[2][2][4][2];
#pragma unroll
    for (int a = 0; a < 2; ++a)
#pragma unroll
        for (int b = 0; b < 2; ++b)
#pragma unroll
            for (int m = 0; m < 4; ++m)
#pragma unroll
                for (int n = 0; n < 2; ++n) acc[a][b][m][n] = (f32x4){0.f, 0.f, 0.f, 0.f};
    bf16x8 At[4][2], B0[2][2], B1[2][2];
    const char* cA = (const char*)g.A + (size_t)cur.pm * tstep + (size_t)cur.ko * 2; const char* cB = (const char*)g.Bt + (size_t)cur.pn * tstep + (size_t)cur.ko * 2;
    S.a_ready(cur);
    PG8_STAGE(PG8_SB(0, 0), cB, voffB); PG8_STAGE(PG8_SA(0, 0), cA, voffA); PG8_STAGE(PG8_SB(0, 1), cB + hstep, voffB); PG8_STAGE(PG8_SA(0, 1), cA + hstep, voffA);
    if (wr == 1) PG8_BAR;
    PG8_WAIT_V(4); PG8_BAR;
    PG8_STAGE(PG8_SB(1, 0), cB + kstep, voffB); PG8_STAGE(PG8_SA(1, 0), cA + kstep, voffA); PG8_STAGE(PG8_SB(1, 1), cB + hstep + kstep, voffB);
    PG8_WAIT_V(6); PG8_BAR;
    PG8_STAMP();
    for (;;) {
        const bool has_next = S.next(ui + 1, nxt);
        const char* nA = has_next ? (const char*)g.A + (size_t)nxt.pm * tstep + (size_t)nxt.ko * 2 : cA; const char* nB = has_next ? (const char*)g.Bt + (size_t)nxt.pn * tstep + (size_t)nxt.ko * 2 : cB;
#pragma unroll 1
        for (int t = 0; t < nt; t += 2) {
            const bool last = (t == nt - 2);
            const char* a1 = cA + (size_t)(t + 1) * kstep;
            const char* a2 = last ? nA : cA + (size_t)(t + 2) * kstep; const char* b2 = last ? nB : cB + (size_t)(t + 2) * kstep;
            const char* a3 = a2 + kstep; const char* b3 = b2 + kstep;
            if (last && has_next) S.a_ready(nxt);
            PG8_LDB(B0, 0, 0); PG8_SCHED; PG8_LDA(At, 0, 0); PG8_STAGE(PG8_SA(1, 1), a1 + hstep, voffA);
            PG8_WAIT_L(8); PG8_BAR; PG8_WAIT_L(0); PG8_MMA(0, 0, At, B0); PG8_BAR; PG8_SCHED;
            PG8_LDB(B1, 0, 1); PG8_STAGE(PG8_SB(0, 0), b2, voffB);
            PG8_BAR; PG8_WAIT_L(0); PG8_MMA(0, 1, At, B1); PG8_BAR;
            PG8_LDA(At, 0, 1); PG8_STAGE(PG8_SA(0, 0), a2, voffA);
            PG8_BAR; PG8_WAIT_L(0); PG8_MMA(1, 0, At, B0); PG8_BAR; PG8_SCHED;
            PG8_STAGE(PG8_SB(0, 1), b2 + hstep, voffB);
            PG8_WAIT_V(6); PG8_BAR; PG8_MMA(1, 1, At, B1); PG8_BAR;
            PG8_LDB(B0, 1, 0); PG8_SCHED; PG8_LDA(At, 1, 0); PG8_STAGE(PG8_SA(0, 1), a2 + hstep, voffA);
            PG8_WAIT_L(8); PG8_BAR; PG8_WAIT_L(0); PG8_MMA(0, 0, At, B0); PG8_BAR; PG8_SCHED;
            PG8_LDB(B1, 1, 1); PG8_STAGE(PG8_SB(1, 0), b3, voffB);
            PG8_BAR; PG8_WAIT_L(0); PG8_MMA(0, 1, At, B1); PG8_BAR;
            PG8_LDA(At, 1, 1); PG8_STAGE(PG8_SA(1, 0), a3, voffA);
            PG8_BAR; PG8_WAIT_L(0); PG8_MMA(1, 0, At, B0); PG8_BAR; PG8_SCHED;
            PG8_STAGE(PG8_SB(1, 1), b3 + hstep, voffB);
            PG8_WAIT_V(6); PG8_BAR; PG8_MMA(1, 1, At, B1); PG8_BAR;
        }
        PG8_STAMP();
        if constexpr (!Epi::AFTER_DRAIN) { E(acc, cur, wr, wc, fr, fq); S.done(cur); }
        PG8_STAMP();
        if (!has_next) break;
#pragma unroll
        for (int a = 0; a < 2; ++a)
#pragma unroll
            for (int b = 0; b < 2; ++b)
#pragma unroll
                for (int m = 0; m < 4; ++m)
#pragma unroll
                    for (int n = 0; n < 2; ++n) acc[a][b][m][n] = (f32x4){0.f, 0.f, 0.f, 0.f};
        cur = nxt; cA = nA; cB = nB; ++ui;
    }
    PG8_WAIT_V(0);
    if (wr == 0) PG8_BAR;
    PG8_BAR;
    if constexpr (Epi::AFTER_DRAIN) { E.fused(acc, cur, wr, wc, fr, fq, lds, wid, lane); S.done(cur); }
    PG8_STAMP();
    if (STAMP && wid == 0) { stamps[lane] = lane < nts ? (((unsigned long long)(unsigned)ts_hi << 32) | (unsigned)ts_lo) : 0ull;
        if (lane == 62) stamps[62] = rt_entry; if (lane == 63) stamps[63] = (unsigned long long)wall_clock64(); }
#undef PG8_STAMP
#undef PG8_SA
#undef PG8_SB
#undef PG8_STAGE
#undef PG8_LDA
#undef PG8_LDB
#undef PG8_MMA
#undef PG8_WAIT_V
#undef PG8_WAIT_L
#undef PG8_BAR
#undef PG8_SCHED
}
}

#define LAS __attribute__((address_space(3)))
typedef unsigned short bf16_t;
typedef short bf16x8 __attribute__((ext_vector_type(8)));
typedef float f32x4 __attribute__((ext_vector_type(4)));
typedef unsigned u32x4 __attribute__((ext_vector_type(4)));
typedef unsigned u32x2 __attribute__((ext_vector_type(2)));

constexpr int M_TOK = 16384, T_SEQ = 8192, DM = 4096, NPROJ = 10624, NPAD = 10752, FFD = 16384;
constexpr int GW = 2048, RW = 2048, PSW = 6528, LK = 384, LN_ = 6144;
constexpr int LDS_BYTES = 151568, NTHREADS = 512, NWAVES = 8;

constexpr size_t OFF_W1T = 0;
constexpr size_t OFF_W2T = OFF_W1T + (size_t)FFD * DM * 2;
constexpr size_t OFF_WOT = OFF_W2T + (size_t)FFD * DM * 2;
constexpr size_t OFF_BT2 = OFF_WOT + (size_t)DM * DM * 2;
constexpr size_t OFF_H   = OFF_BT2 + (size_t)LN_ * LK * 2;
constexpr size_t OFF_WIN = OFF_H + (size_t)M_TOK * DM * 2;
constexpr size_t OFF_Z   = OFF_WIN + (size_t)NPAD * DM * 2;
constexpr size_t OFF_PS  = OFF_Z + (size_t)M_TOK * DM * 2;
constexpr size_t OFF_Y   = OFF_PS + (size_t)M_TOK * PSW * 2;
constexpr size_t OFF_A2  = OFF_Y + (size_t)M_TOK * DM * 2;
constexpr size_t OFF_ST  = OFF_A2 + (size_t)M_TOK * LK * 2;
constexpr size_t OFF_SS1 = OFF_ST + (size_t)M_TOK * 8;
constexpr size_t OFF_SS2 = OFF_SS1 + (size_t)M_TOK * 64 * 4;
constexpr size_t OFF_BAR = OFF_SS2 + (size_t)M_TOK * 64 * 4;
constexpr size_t WS_END  = OFF_BAR + 16384;
constexpr size_t OFF_BON = OFF_SS1;
constexpr size_t OFF_LO  = OFF_H;
constexpr size_t OFF_YRAW = OFF_Z;
constexpr size_t OFF_MIX = OFF_PS;
constexpr size_t OFF_HID = OFF_WIN;
constexpr size_t OFF_F   = OFF_H;
static_assert(OFF_HID + (size_t)M_TOK * FFD * 2 <= OFF_A2, "hid overflows");
static_assert(OFF_LO + (size_t)M_TOK * LN_ * 2 <= OFF_Z, "LO fits H + WinT");
static_assert(WS_END <= (size_t)1073741824, "workspace");

struct Params {
    const float* x; const float* pre_mix_g; const float* w_in; const float* mu; const float* ln_g; const float* ln_b;
    const float* ws; const float* bs; const float* w0; const float* w_up; const float* a0; const float* a_up; const float* g_up;
    const float* k_k; const float* k_a; const float* r_k; const float* lnx_g; const float* lnx_b; const float* w_out;
    const float* post_mix_g; const float* pre_ffn_g; const float* w_ff1; const float* w_ff2; const float* post_ffn_g;
    float* out; unsigned char* wsb; int ph_lo, ph_hi, coop, pad;
};

typedef float f32x2v_ __attribute__((ext_vector_type(2))); typedef __bf16 bf16x2v_ __attribute__((ext_vector_type(2)));
__device__ __forceinline__ unsigned pk2(float lo, float hi) { const f32x2v_ v = {lo, hi}; return __builtin_bit_cast(unsigned, __builtin_convertvector(v, bf16x2v_)); }
__device__ __forceinline__ float bflo(unsigned u) { return __uint_as_float(u << 16); }
__device__ __forceinline__ float bfhi(unsigned u) { return __uint_as_float(u & 0xffff0000u); }
__device__ __forceinline__ float bf1(bf16_t b) { return __uint_as_float(((unsigned)b) << 16); }
__device__ __forceinline__ bf16_t f2bf(float f) { return (bf16_t)(pk2(f, 0.f) & 0xffffu); }
__device__ __forceinline__ float wave_sum(float v) {
#pragma unroll
    for (int o = 1; o < 64; o <<= 1) v += __shfl_xor(v, o);
    return v;
}
template <int CTRL> __device__ __forceinline__ float dpp_mov(float x) { return __builtin_bit_cast(float, __builtin_amdgcn_update_dpp(0, __builtin_bit_cast(int, x), CTRL, 0xf, 0xf, true)); }
__device__ __forceinline__ float red16(float v) {
    v += dpp_mov<0xB1>(v);
    v += dpp_mov<0x4E>(v);
    v += dpp_mov<0x141>(v);
    v += dpp_mov<0x140>(v);
    return v;
}
#define LDS_WAIT() asm volatile("s_waitcnt lgkmcnt(0)" ::: "memory")

__device__ __forceinline__ float gelu_tanh(float x) {
    const float u = 0.7978845608028654f * (x + 0.044715f * x * x * x);
    const float e = __builtin_amdgcn_exp2f(-2.0f * 1.4426950408889634f * u);
    return x * __builtin_amdgcn_rcpf(1.0f + e);
}
struct EpiProj {
    static constexpr bool PERM = true, AFTER_DRAIN = false;
    bf16_t* Z; bf16_t* PS;
    __device__ __forceinline__ void operator()(const f32x4 (&acc)[2][2][4][2], const pg8::Unit& u, int wr, int wc, int fr, int fq) const {
        const int row0 = u.pm * 256 + wr * 64 + fr, colt = u.pn * 256 + wc * 32 + 8 * fq;
        const bool isz = u.pn < 16;
#pragma unroll
        for (int ai = 0; ai < 2; ++ai)
#pragma unroll
            for (int m = 0; m < 4; ++m) { const size_t row = (size_t)(row0 + ai * 128 + m * 16);
#pragma unroll
                for (int bj = 0; bj < 2; ++bj) { f32x4 v0 = acc[ai][bj][m][0], v1 = acc[ai][bj][m][1]; const int col = colt + bj * 128;
                    if (isz) {
#pragma unroll
                        for (int j = 0; j < 4; ++j) { v0[j] = gelu_tanh(v0[j]); v1[j] = gelu_tanh(v1[j]); }
                        u32x4 w; w.x = pk2(v0[0], v0[1]); w.y = pk2(v0[2], v0[3]); w.z = pk2(v1[0], v1[1]); w.w = pk2(v1[2], v1[3]);
                        *(u32x4*)(Z + row * DM + col) = w;
                    } else { const int c2 = col - 4096;
                        if (c2 < PSW) { u32x4 w; w.x = pk2(v0[0], v0[1]); w.y = pk2(v0[2], v0[3]); w.z = pk2(v1[0], v1[1]); w.w = pk2(v1[2], v1[3]);
                            *(u32x4*)(PS + row * PSW + c2) = w; } } } }
    }
};
__device__ __forceinline__ unsigned pkh2(float a, float b) { const _Float16 ha = (_Float16)a, hb = (_Float16)b; return (unsigned)__builtin_bit_cast(unsigned short, ha) | ((unsigned)__builtin_bit_cast(unsigned short, hb) << 16); }
__device__ __forceinline__ float decay_rate(float val) {
    const float xx = -val; const float sp = fmaxf(xx, 0.f) + __logf(1.0f + __expf(-fabsf(xx))); return __expf(-sp - 0.5f);
}
__device__ __forceinline__ float sigmoidf_(float v) { return __builtin_amdgcn_rcpf(1.0f + __expf(-v)); }
struct EpiF16 {
    static constexpr bool PERM = true, AFTER_DRAIN = false;
    unsigned short* O; const float* w0; const float* a0; int pn0;
    __device__ __forceinline__ void operator()(const f32x4 (&acc)[2][2][4][2], const pg8::Unit& u, int wr, int wc, int fr, int fq) const {
        const int pn = u.pn + pn0; const int row0 = u.pm * 256 + wr * 64 + fr, colt = pn * 256 + wc * 32 + 8 * fq;
        const int kind = pn >> 3;
        const float* bias = kind == 0 ? w0 : a0; const float scale = kind == 0 ? 0.6065306597126334f : 1.0f;
#pragma unroll
        for (int bj = 0; bj < 2; ++bj) { const int col = colt + bj * 128; f32x4 b0 = {0.f, 0.f, 0.f, 0.f}, b1 = b0;
            if (kind < 2) { b0 = *(const f32x4*)(bias + (col & 2047)); b1 = *(const f32x4*)(bias + (col & 2047) + 4); }
#pragma unroll
            for (int ai = 0; ai < 2; ++ai)
#pragma unroll
                for (int m = 0; m < 4; ++m) { const size_t row = (size_t)(row0 + ai * 128 + m * 16); f32x4 v0 = acc[ai][bj][m][0], v1 = acc[ai][bj][m][1];
                    if (kind < 2) {
#pragma unroll
                        for (int j = 0; j < 4; ++j) { v0[j] = scale * sigmoidf_(v0[j] + b0[j]); v1[j] = scale * sigmoidf_(v1[j] + b1[j]); } }
                    u32x4 w; w.x = pkh2(v0[0], v0[1]); w.y = pkh2(v0[2], v0[3]); w.z = pkh2(v1[0], v1[1]); w.w = pkh2(v1[2], v1[3]);
                    *(u32x4*)(O + row * LN_ + col) = w; asm volatile("" ::: "memory"); } }
    }
};
struct EpiNormPart {
    static constexpr bool PERM = true, AFTER_DRAIN = false;
    bf16_t* O; float* part;
    __device__ __forceinline__ void operator()(const f32x4 (&acc)[2][2][4][2], const pg8::Unit& u, int wr, int wc, int fr, int fq) const {
        const int row0 = u.pm * 256 + wr * 64 + fr, colt = u.pn * 256 + wc * 32 + 8 * fq;
#pragma unroll
        for (int ai = 0; ai < 2; ++ai)
#pragma unroll
            for (int m = 0; m < 4; ++m) { const size_t row = (size_t)(row0 + ai * 128 + m * 16); float s = 0.f;
#pragma unroll
                for (int bj = 0; bj < 2; ++bj) { const f32x4 v0 = acc[ai][bj][m][0], v1 = acc[ai][bj][m][1];
                    s += (v0[0] * v0[0] + v0[1] * v0[1]) + (v0[2] * v0[2] + v0[3] * v0[3]) + (v1[0] * v1[0] + v1[1] * v1[1]) + (v1[2] * v1[2] + v1[3] * v1[3]);
                    u32x4 w; w.x = pk2(v0[0], v0[1]); w.y = pk2(v0[2], v0[3]); w.z = pk2(v1[0], v1[1]); w.w = pk2(v1[2], v1[3]);
                    *(u32x4*)(O + row * DM + colt + bj * 128) = w; }
                s += __shfl_xor(s, 16); s += __shfl_xor(s, 32);
                if (fq == 0) part[row * 64 + u.pn * 4 + wc] = s; }
    }
};
struct EpiRelu2 {
    static constexpr bool PERM = true, AFTER_DRAIN = false;
    bf16_t* O;
    __device__ __forceinline__ void operator()(const f32x4 (&acc)[2][2][4][2], const pg8::Unit& u, int wr, int wc, int fr, int fq) const {
        const int row0 = u.pm * 256 + wr * 64 + fr, colt = u.pn * 256 + wc * 32 + 8 * fq;
#pragma unroll
        for (int ai = 0; ai < 2; ++ai)
#pragma unroll
            for (int m = 0; m < 4; ++m) { const size_t row = (size_t)(row0 + ai * 128 + m * 16);
#pragma unroll
                for (int bj = 0; bj < 2; ++bj) { f32x4 v0 = acc[ai][bj][m][0], v1 = acc[ai][bj][m][1];
#pragma unroll
                    for (int j = 0; j < 4; ++j) { const float a = fmaxf(v0[j], 0.f), b = fmaxf(v1[j], 0.f); v0[j] = a * a; v1[j] = b * b; }
                    u32x4 w; w.x = pk2(v0[0], v0[1]); w.y = pk2(v0[2], v0[3]); w.z = pk2(v1[0], v1[1]); w.w = pk2(v1[2], v1[3]);
                    *(u32x4*)(O + row * FFD + colt + bj * 128) = w; } }
    }
};

#define XB_TMO      128
#define XB_XCNT(j)  (256  + 64 * (j))
#define XB_XSUB(j)  (1280 + 64 * (j))
#define XB_XGEN(j)  (2304 + 64 * (j))
#define XB_TOP      3328
#define XB_TOPGEN   3392
#define XCD_BAR_WORDS 3456
#define XB_SPIN_CAP (1u << 18)
__device__ __forceinline__ unsigned xb_ld(unsigned* p)              { return __hip_atomic_load(p, __ATOMIC_RELAXED, __HIP_MEMORY_SCOPE_AGENT); }
__device__ __forceinline__ unsigned xb_add(unsigned* p, unsigned v) { return __hip_atomic_fetch_add(p, v, __ATOMIC_RELAXED, __HIP_MEMORY_SCOPE_AGENT); }
__device__ __forceinline__ unsigned xb_xcc_id() { return (unsigned)__builtin_amdgcn_s_getreg((3 << 11) | 20) & 0xFu; }
#define XB_SPIN(cond, bar) do { unsigned _sp = 0; while (cond) { __builtin_amdgcn_s_sleep(1); \
    if ((++_sp & 255u) == 0u) { if (xb_ld(&(bar)[XB_TMO])) break; if (_sp > XB_SPIN_CAP) { atomicAdd(&(bar)[XB_TMO], 1u); break; } } } } while (0)

struct XcdBarrier {
    unsigned* bar; unsigned x;
    volatile LAS unsigned* st;
};

__device__ __forceinline__ XcdBarrier xcd_barrier_post(unsigned* bar, volatile LAS unsigned* st) {
    XcdBarrier b; b.bar = bar; b.x = xb_xcc_id(); b.st = st;
    if (threadIdx.x == 0) (void)xb_add(&bar[XB_XCNT(b.x)], 1u);
    return b;
}
__device__ __forceinline__ void xcd_barrier_complete(unsigned* bar, unsigned x, unsigned& nloc, unsigned& nx) {
    const unsigned G = gridDim.x * gridDim.y * gridDim.z;
    unsigned sum, cnt, mine, sp = 0u;
    for (;;) {
        sum = 0u; cnt = 0u; mine = 0u;
#pragma unroll
        for (unsigned j = 0; j < 16; ++j) { const unsigned c = xb_ld(&bar[XB_XCNT(j)]); sum += c; cnt += (c > 0u) ? 1u : 0u; mine = (j == x) ? c : mine; }
        if (sum == G) break;
        __builtin_amdgcn_s_sleep(1);
        if ((++sp & 255u) == 0u) { if (xb_ld(&bar[XB_TMO])) break; if (sp > XB_SPIN_CAP) { atomicAdd(&bar[XB_TMO], 1u); break; } }
    }
    nloc = mine > 0u ? mine : 1u; nx = cnt > 0u ? cnt : 1u;
}

__device__ __forceinline__ void xcd_barrier(const XcdBarrier& b) {
    asm volatile("s_waitcnt vmcnt(0)" ::: "memory");
    __syncthreads();
    if (threadIdx.x == 0) {
        unsigned* bar = b.bar;
        __builtin_amdgcn_s_waitcnt(0);
        unsigned nloc = b.st[0], nx = b.st[1];
        if (nloc == 0u) { xcd_barrier_complete(bar, b.x, nloc, nx); b.st[0] = nloc; b.st[1] = nx; }
        const unsigned old = xb_add(&bar[XB_XSUB(b.x)], 1u);
        const unsigned gen = old / nloc;
        if (old + 1u == (gen + 1u) * nloc) {
            __builtin_amdgcn_fence(__ATOMIC_RELEASE, "agent");
            asm volatile("s_waitcnt vmcnt(0)" ::: "memory");
            const unsigned og = xb_add(&bar[XB_TOP], 1u);
            const unsigned tg = og / nx;
            if (og + 1u == (tg + 1u) * nx) xb_add(&bar[XB_TOPGEN], 1u);
            else XB_SPIN(xb_ld(&bar[XB_TOPGEN]) == tg, bar);
            __builtin_amdgcn_fence(__ATOMIC_ACQUIRE, "agent");
            xb_add(&bar[XB_XGEN(b.x)], 1u);
            asm volatile("s_waitcnt vmcnt(0)" ::: "memory");
        } else {
            XB_SPIN(xb_ld(&bar[XB_XGEN(b.x)]) == gen, bar);
            __builtin_amdgcn_fence(__ATOMIC_ACQUIRE, "agent");
            asm volatile("s_waitcnt vmcnt(0)" ::: "memory");
        }
    }
    __syncthreads();
}


typedef const __attribute__((address_space(4))) Params* KP;
__device__ __forceinline__ KP kparams() { unsigned long long q = (unsigned long long)__builtin_amdgcn_kernarg_segment_ptr(); asm volatile("" : "+s"(q) :: "memory"); return (KP)q; }
__device__ __forceinline__ void transpose_item(const float* W, int K, int N, bf16_t* WT, LAS float* scr, int item, int lane) {
    const int nblk = N / 32, kb = item / nblk, nb = item % nblk, k0 = 64 * kb, n0 = 32 * nb;
#pragma unroll 8
    for (int i = 0; i < 32; ++i) { const int kk = 2 * i + (lane >> 5); scr[kk * 33 + (lane & 31)] = W[(size_t)(k0 + kk) * N + n0 + (lane & 31)]; }
    LDS_WAIT();
    const int c = lane & 7;
#pragma unroll
    for (int j = 0; j < 4; ++j) { const int n = (lane >> 3) + 8 * j; const LAS float* s = scr + (8 * c) * 33 + n;
        u32x4 o; o.x = pk2(s[0 * 33], s[1 * 33]); o.y = pk2(s[2 * 33], s[3 * 33]); o.z = pk2(s[4 * 33], s[5 * 33]); o.w = pk2(s[6 * 33], s[7 * 33]);
        *(u32x4*)(WT + (size_t)(n0 + n) * K + k0 + 8 * c) = o; }
    LDS_WAIT();
}

__device__ __forceinline__ void phase0(KP p, unsigned char* lds, int gw, int NGW, int lane, int wave) {
    unsigned char* ws = p->wsb;
    LAS float* scr = (LAS float*)((LAS unsigned char*)lds + wave * 8448);
    bf16_t* WinT = (bf16_t*)(ws + OFF_WIN); bf16_t* WoT = (bf16_t*)(ws + OFF_WOT); bf16_t* W1T = (bf16_t*)(ws + OFF_W1T); bf16_t* W2T = (bf16_t*)(ws + OFF_W2T);
    constexpr int I_IN = (DM / 64) * (NPROJ / 32), I_O = (DM / 64) * (DM / 32), I_1 = (DM / 64) * (FFD / 32), I_2 = (FFD / 64) * (DM / 32);
    constexpr int NITEMS = I_IN;
    for (int it = gw; it < NITEMS; it += NGW) {
        int r = it;
        transpose_item(p->w_in, DM, NPROJ, WinT, scr, r, lane);
    }
    { u32x4* z = (u32x4*)(WinT + (size_t)NPROJ * DM); const size_t n16 = (size_t)(NPAD - NPROJ) * DM * 2 / 16; const u32x4 zero = {0u, 0u, 0u, 0u};
      for (size_t i = (size_t)gw * 64 + lane; i < n16; i += (size_t)NGW * 64) z[i] = zero; }
    { bf16_t* BT2 = (bf16_t*)(ws + OFF_BT2);
      for (size_t i = (size_t)gw * 64 + lane; i < (size_t)LN_ * LK; i += (size_t)NGW * 64) { const int n = (int)(i / LK), k = (int)(i % LK); float v = 0.f;
          if (n < 2048) { if (k < 64) v = p->w_up[(size_t)k * RW + n]; }
          else if (n < 4096) { if (k >= 64 && k < 128) v = p->a_up[(size_t)(k - 64) * RW + (n - 2048)]; }
          else { if (k >= 128) v = p->g_up[(size_t)(k - 128) * RW + (n - 4096)]; }
          BT2[i] = f2bf(v); } }
    bf16_t* H = (bf16_t*)(ws + OFF_H);
    for (int row = gw; row < M_TOK; row += NGW) {
        const float* gp0 = p->pre_mix_g; asm volatile("" : "+s"(gp0));
        const f32x4* xr = (const f32x4*)(p->x + (size_t)row * DM) + lane; f32x4 v[16]; float s = 0.f;
#pragma unroll
        for (int j = 0; j < 16; ++j) { v[j] = xr[64 * j]; s += (v[j].x * v[j].x + v[j].y * v[j].y) + (v[j].z * v[j].z + v[j].w * v[j].w); }
        const float rs = rsqrtf(wave_sum(s) * (1.0f / DM) + 1e-6f);
        u32x2* o = (u32x2*)(H + (size_t)row * DM) + lane;
#pragma unroll
        for (int j = 0; j < 16; ++j) { const f32x4 g = ((const f32x4*)gp0)[lane + 64 * j]; u32x2 w; w.x = pk2(v[j].x * rs * g.x, v[j].y * rs * g.y); w.y = pk2(v[j].z * rs * g.z, v[j].w * rs * g.w); o[64 * j] = w; }
    }
}

__device__ __forceinline__ void phase2(KP p, int gw, int NGW, int lane) {
    unsigned char* ws = p->wsb;
    const bf16_t* Z = (const bf16_t*)(ws + OFF_Z); const bf16_t* PS = (const bf16_t*)(ws + OFF_PS); bf16_t* A2 = (bf16_t*)(ws + OFF_A2); float* ST = (float*)(ws + OFF_ST);
    for (int row = gw; row < M_TOK; row += NGW) {
        const u32x4* zr = (const u32x4*)(Z + (size_t)row * DM + 2048) + lane; float v[32]; float s = 0.f;
#pragma unroll
        for (int j = 0; j < 4; ++j) { const u32x4 q = zr[64 * j];
            v[8 * j + 0] = bflo(q.x); v[8 * j + 1] = bfhi(q.x); v[8 * j + 2] = bflo(q.y); v[8 * j + 3] = bfhi(q.y); v[8 * j + 4] = bflo(q.z); v[8 * j + 5] = bfhi(q.z); v[8 * j + 6] = bflo(q.w); v[8 * j + 7] = bfhi(q.w); }
#pragma unroll
        for (int j = 0; j < 32; ++j) s += v[j];
        const float mean = wave_sum(s) * (1.0f / 2048.0f); float s2 = 0.f;
#pragma unroll
        for (int j = 0; j < 32; ++j) { const float d = v[j] - mean; s2 += d * d; }
        const float rstd = rsqrtf(wave_sum(s2) * (1.0f / 2048.0f) + 1e-5f);
        if (lane == 0) { ST[2 * row] = mean; ST[2 * row + 1] = rstd; }
        const bool has_prev = (row % T_SEQ) != 0;
#pragma unroll
        for (int i = 0; i < 6; ++i) { const int c = lane + 64 * i; const float cur = bf1(PS[(size_t)row * PSW + 6144 + c]);
            const float prev = has_prev ? bf1(PS[(size_t)(row - 1) * PSW + 6144 + c]) : 0.f; const float m = p->mu[6144 + c];
            float val = cur + (prev - cur) * m;
            if (i == 0) val = 1.0f - 2.0f * __builtin_amdgcn_rcpf(1.0f + __expf(2.0f * val));
            else if (i >= 2) val = sigmoidf_(val);
            A2[(size_t)row * LK + c] = f2bf(val); }
    }
}

__device__ __forceinline__ void phase_gmlp(KP p, unsigned char* ldsg, int tid, int lane, int wave) {
    unsigned char* ws = p->wsb;
    const bf16_t* Z = (const bf16_t*)(ws + OFF_Z); const float* ST = (const float*)(ws + OFF_ST); bf16_t* Y = (bf16_t*)(ws + OFF_Y);
    LAS bf16_t* Wm = (LAS bf16_t*)(LAS unsigned char*)ldsg; LAS bf16_t* Vt = Wm + 128 * 136;
    const int fr = lane & 15, fq = lane >> 4;
    const int si = tid >> 2, sb = (tid & 3) * 32;
    f32x4 wreg[8], greg[8], breg[8]; u32x4 zreg[4]; float mean = 0.f, rstd = 0.f;
#define GM_LOAD(UNIT) do { const int h_ = (UNIT) & 15, tok_ = ((UNIT) >> 4) * 128 + si; \
        const f32x4* wsrc_ = (const f32x4*)(p->ws + ((size_t)h_ * 128 + si) * 128 + sb); const u32x4* zsrc_ = (const u32x4*)(Z + (size_t)tok_ * DM + 2048 + h_ * 128 + sb); \
        const f32x4* gsrc_ = (const f32x4*)(p->ln_g + h_ * 128 + sb); const f32x4* bsrc_ = (const f32x4*)(p->ln_b + h_ * 128 + sb); \
        _Pragma("unroll") for (int q_ = 0; q_ < 8; ++q_) { wreg[q_] = wsrc_[q_]; greg[q_] = gsrc_[q_]; breg[q_] = bsrc_[q_]; } \
        _Pragma("unroll") for (int q_ = 0; q_ < 4; ++q_) zreg[q_] = zsrc_[q_]; \
        mean = ST[2 * tok_]; rstd = ST[2 * tok_ + 1]; } while (0)
    int unit = blockIdx.x;
    if (unit < 2048) GM_LOAD(unit);
    for (; unit < 2048; unit += gridDim.x) {
        const int h = unit & 15, bn = unit >> 4, tok0 = bn * 128;
        { const bool keep = (sb >> 6) <= (si >> 6);
#pragma unroll
          for (int q = 0; q < 4; ++q) { f32x4 a = wreg[2 * q], b = wreg[2 * q + 1]; if (!keep) { a = (f32x4){0.f, 0.f, 0.f, 0.f}; b = a; }
              u32x4 o; o.x = pk2(a.x, a.y); o.y = pk2(a.z, a.w); o.z = pk2(b.x, b.y); o.w = pk2(b.z, b.w); *(LAS u32x4*)(Wm + si * 136 + sb + 8 * q) = o; } }
        {
#pragma unroll
          for (int q = 0; q < 4; ++q) { const u32x4 z8 = zreg[q]; const float zf[8] = {bflo(z8.x), bfhi(z8.x), bflo(z8.y), bfhi(z8.y), bflo(z8.z), bfhi(z8.z), bflo(z8.w), bfhi(z8.w)};
              const f32x4 g0 = greg[2 * q], g1 = greg[2 * q + 1], b0 = breg[2 * q], b1 = breg[2 * q + 1];
#pragma unroll
              for (int e = 0; e < 8; ++e) { const float gg = e < 4 ? g0[e & 3] : g1[e & 3], bb = e < 4 ? b0[e & 3] : b1[e & 3];
                  Vt[(sb + 8 * q + e) * 136 + si] = f2bf((zf[e] - mean) * rstd * gg + bb); } } }
        __syncthreads();
        const int nxt = unit + gridDim.x;
        if (nxt < 2048) GM_LOAD(nxt);
        const int i0 = 16 * wave; const int tok = tok0 + i0 + fr; const float bias = p->bs[h * 128 + i0 + fr];
        u32x2 ureg[8];
#pragma unroll
        for (int ct = 0; ct < 8; ++ct) ureg[ct] = *(const u32x2*)(Z + (size_t)tok * DM + h * 128 + ct * 16 + 4 * fq);
        f32x4 acc[8];
#pragma unroll
        for (int ct = 0; ct < 8; ++ct) acc[ct] = (f32x4){0.f, 0.f, 0.f, 0.f};
        const int nks = (wave < 4) ? 2 : 4;
        for (int ks = 0; ks < nks; ++ks) { const bf16x8 wf = *(const LAS bf16x8*)(Wm + (i0 + fr) * 136 + ks * 32 + fq * 8);
#pragma unroll
            for (int ct = 0; ct < 8; ++ct) { const bf16x8 vf = *(const LAS bf16x8*)(Vt + (ct * 16 + fr) * 136 + ks * 32 + fq * 8);
                acc[ct] = __builtin_amdgcn_mfma_f32_16x16x32_bf16(vf, wf, acc[ct], 0, 0, 0); } }
#pragma unroll
        for (int ct = 0; ct < 8; ++ct) { const int c = h * 128 + ct * 16 + 4 * fq; const u32x2 uu = ureg[ct];
            u32x2 o; o.x = pk2(bflo(uu.x) * (acc[ct][0] + bias), bfhi(uu.x) * (acc[ct][1] + bias)); o.y = pk2(bflo(uu.y) * (acc[ct][2] + bias), bfhi(uu.y) * (acc[ct][3] + bias));
            *(u32x2*)(Y + (size_t)tok * DM + c) = o; }
        __syncthreads();
    }
#undef GM_LOAD
}

constexpr int BG_O = (DM / 64) * (DM / 64), BG_1 = (DM / 64) * (FFD / 64), BG_2 = (FFD / 64) * (DM / 64), BG_ITEMS = BG_O + BG_1 + BG_2;
struct BgRegs { float v[16]; };
__device__ __forceinline__ void bg_locate(KP p, int item, const float*& W, bf16_t*& WT, int& K, int& N, int& k0, int& n0) {
    unsigned char* ws = p->wsb; int r = item;
    if (r < BG_O) { W = p->w_out; WT = (bf16_t*)(ws + OFF_WOT); K = DM; N = DM; }
    else { r -= BG_O; if (r < BG_1) { W = p->w_ff1; WT = (bf16_t*)(ws + OFF_W1T); K = DM; N = FFD; } else { r -= BG_1; W = p->w_ff2; WT = (bf16_t*)(ws + OFF_W2T); K = FFD; N = DM; } }
    const int lg = (N == DM) ? 6 : 8; k0 = (r >> lg) * 64; n0 = (r & ((1 << lg) - 1)) * 64;
}
__device__ __forceinline__ void bg_load(KP p, BgRegs& R, int item, int w4, int lane) {
    const float* W; bf16_t* WT; int K, N, k0, n0; bg_locate(p, item, W, WT, K, N, k0, n0);
    const __amdgpu_buffer_rsrc_t rs = __builtin_amdgcn_make_buffer_rsrc((void*)W, 0, 0x7fffffff, 0x00020000);
    const unsigned vo = (unsigned)lane * 4u, sbase = (unsigned)(((k0 + 16 * w4) * N + n0) * 4), rowb = (unsigned)N * 4u;
#pragma unroll
    for (int i = 0; i < 16; ++i) R.v[i] = __builtin_bit_cast(float, __builtin_amdgcn_raw_buffer_load_b32(rs, vo, sbase + (unsigned)i * rowb, 0));
}
__device__ __forceinline__ void bg_store(KP p, const BgRegs& R, int item, int w4, int lane) {
    const float* W; bf16_t* WT; int K, N, k0, n0; bg_locate(p, item, W, WT, K, N, k0, n0);
    u32x4 a, b; a.x = pk2(R.v[0], R.v[1]); a.y = pk2(R.v[2], R.v[3]); a.z = pk2(R.v[4], R.v[5]); a.w = pk2(R.v[6], R.v[7]);
    b.x = pk2(R.v[8], R.v[9]); b.y = pk2(R.v[10], R.v[11]); b.z = pk2(R.v[12], R.v[13]); b.w = pk2(R.v[14], R.v[15]);
    u32x4* dst = (u32x4*)(WT + (size_t)(n0 + lane) * K + k0 + 16 * w4); dst[0] = a; dst[1] = b;
}
constexpr int SC = 32;
constexpr int SBUF = 43008, L_WW = 8192, L_BB = 16384, L_KP = 24576, L_RR = 32768, L_VV = 40960, L_YP = 2 * SBUF, YPB = 32768;
static_assert(L_YP + 2 * YPB <= LDS_BYTES, "scan LDS");
struct ScanConst { float mur[8], muk[8], muv[8], kk_[8], ka[8], rk[8]; };
typedef _Float16 h8v __attribute__((ext_vector_type(8)));
struct ScanRaw { u32x4 rc, kc, vc, rp, kp_, vp; h8v e8, a8; };
__device__ __forceinline__ void scan_load(ScanRaw& R, const bf16_t* PS, const _Float16* LO, size_t tok, bool hasp, int hc) {
    const bf16_t* row = PS + tok * PSW + hc; const bf16_t* prow = row - PSW;
    const u32x4 zero = {0u, 0u, 0u, 0u};
    R.rc = *(const u32x4*)(row); R.kc = *(const u32x4*)(row + 2048); R.vc = *(const u32x4*)(row + 4096);
    R.rp = hasp ? *(const u32x4*)(prow) : zero; R.kp_ = hasp ? *(const u32x4*)(prow + 2048) : zero; R.vp = hasp ? *(const u32x4*)(prow + 4096) : zero;
    R.e8 = *(const h8v*)(LO + tok * LN_ + hc); R.a8 = *(const h8v*)(LO + tok * LN_ + 2048 + hc);
}
typedef __amdgpu_buffer_rsrc_t bufrsrc_t;
__device__ __forceinline__ bufrsrc_t make_rsrc(const void* p) { return __builtin_amdgcn_make_buffer_rsrc((void*)p, 0, 0x7fffffff, 0x00020000); }
struct ScanOff { unsigned r, k, v, e, a; };
__device__ __forceinline__ void scan_load_buf(ScanRaw& R, bufrsrc_t rsP, bufrsrc_t rsL, const ScanOff& o, unsigned soffP, unsigned soffL) {
    R.rc = __builtin_amdgcn_raw_buffer_load_b128(rsP, o.r, soffP, 0); R.kc = __builtin_amdgcn_raw_buffer_load_b128(rsP, o.k, soffP, 0); R.vc = __builtin_amdgcn_raw_buffer_load_b128(rsP, o.v, soffP, 0);
    const unsigned soffPp = soffP - (unsigned)(PSW * 2);
    R.rp = __builtin_amdgcn_raw_buffer_load_b128(rsP, o.r, soffPp, 0); R.kp_ = __builtin_amdgcn_raw_buffer_load_b128(rsP, o.k, soffPp, 0); R.vp = __builtin_amdgcn_raw_buffer_load_b128(rsP, o.v, soffPp, 0);
    R.e8 = __builtin_bit_cast(h8v, __builtin_amdgcn_raw_buffer_load_b128(rsL, o.e, soffL, 0)); R.a8 = __builtin_bit_cast(h8v, __builtin_amdgcn_raw_buffer_load_b128(rsL, o.a, soffL, 0));
}
__device__ __forceinline__ void scan_prep(LAS unsigned char* buf, const ScanConst& C, const ScanRaw& R, int pt, int kb, int q, float* bon) {
    const u32x4 rc = R.rc, kc = R.kc, vc = R.vc, rp = R.rp, kp_ = R.kp_, vp = R.vp; const h8v e8 = R.e8, a8 = R.a8;
    float r[8], k[8], v[8], a[8], kk[8], wv[8], kq[8]; float ss = 0.f;
    const unsigned rcw[4] = {rc.x, rc.y, rc.z, rc.w}, rpw[4] = {rp.x, rp.y, rp.z, rp.w}, kcw[4] = {kc.x, kc.y, kc.z, kc.w}, kpw[4] = {kp_.x, kp_.y, kp_.z, kp_.w};
    const unsigned vcw[4] = {vc.x, vc.y, vc.z, vc.w}, vpw[4] = {vp.x, vp.y, vp.z, vp.w};
#pragma unroll
    for (int e = 0; e < 8; ++e) { const int wq = e >> 1; const bool hi = e & 1;
        const float rcf = hi ? bfhi(rcw[wq]) : bflo(rcw[wq]), rpf = hi ? bfhi(rpw[wq]) : bflo(rpw[wq]);
        const float kcf = hi ? bfhi(kcw[wq]) : bflo(kcw[wq]), kpf = hi ? bfhi(kpw[wq]) : bflo(kpw[wq]);
        const float vcf = hi ? bfhi(vcw[wq]) : bflo(vcw[wq]), vpf = hi ? bfhi(vpw[wq]) : bflo(vpw[wq]);
        r[e] = rcf + (rpf - rcf) * C.mur[e]; k[e] = kcf + (kpf - kcf) * C.muk[e]; v[e] = vcf + (vpf - vcf) * C.muv[e];
        a[e] = (float)a8[e];
        wv[e] = __expf(-(float)e8[e]);
        kk[e] = k[e] * C.kk_[e]; ss += kk[e] * kk[e];
        kq[e] = k[e] * (1.0f + (a[e] - 1.0f) * C.ka[e]); }
    { float bs = 0.f;
#pragma unroll
      for (int e = 0; e < 8; ++e) bs += r[e] * kq[e] * C.rk[e];
      bs += dpp_mov<0xB1>(bs); bs += dpp_mov<0x4E>(bs); bs += dpp_mov<0x141>(bs);
      if (bon) *bon = bs; }
    ss += dpp_mov<0xB1>(ss); ss += dpp_mov<0x4E>(ss); ss += dpp_mov<0x141>(ss);
    const float inv = __builtin_amdgcn_rsqf(fmaxf(ss, 1e-24f));
#pragma unroll
    for (int e = 0; e < 8; ++e) kk[e] *= inv;
    LAS f32x4* d = (LAS f32x4*)(buf + pt * 256 + kb * 4);
    d[0] = (f32x4){kk[0], kk[1], kk[2], kk[3]}; d[1] = (f32x4){kk[4], kk[5], kk[6], kk[7]};
    d[L_WW / 16] = (f32x4){wv[0], wv[1], wv[2], wv[3]}; d[L_WW / 16 + 1] = (f32x4){wv[4], wv[5], wv[6], wv[7]};
    d[L_BB / 16] = (f32x4){kk[0] * a[0], kk[1] * a[1], kk[2] * a[2], kk[3] * a[3]}; d[L_BB / 16 + 1] = (f32x4){kk[4] * a[4], kk[5] * a[5], kk[6] * a[6], kk[7] * a[7]};
    d[L_KP / 16] = (f32x4){kq[0], kq[1], kq[2], kq[3]}; d[L_KP / 16 + 1] = (f32x4){kq[4], kq[5], kq[6], kq[7]};
    d[L_RR / 16] = (f32x4){r[0], r[1], r[2], r[3]}; d[L_RR / 16 + 1] = (f32x4){r[4], r[5], r[6], r[7]};
    if ((kb >> 4) == q) { LAS float* dv = (LAS float*)(buf + L_VV) + (kb & 15) * SC + pt;
#pragma unroll
        for (int e = 0; e < 8; ++e) dv[e * SC] = v[e]; }
}
__device__ __forceinline__ void scan_yreduce(const LAS unsigned char* ypb, float* YR, size_t tokbase, int colbase, int tid2) {
#pragma unroll
    for (int i = 0; i < 2; ++i) { const int o = tid2 + 256 * i, t = o >> 4, rw = o & 15;
        const LAS f32x4* s4 = (const LAS f32x4*)(ypb + (size_t)o * 64);
        const f32x4 a = s4[0], b = s4[1], c = s4[2], d = s4[3];
        const f32x4 z = (a + b) + (c + d);
        YR[(tokbase + t) * RW + colbase + rw] = (z.x + z.y) + (z.z + z.w); }
}
__device__ __forceinline__ void scan_consume(f32x4& S, const LAS unsigned char* buf, LAS unsigned char* ypb, int j, int rl, int wave, int lane) {
    const LAS f32x4* base = (const LAS f32x4*)(buf) + j;
    const LAS f32x4* vb4 = (const LAS f32x4*)(buf + L_VV) + rl * (SC / 4);
    LAS float* yp = (LAS float*)(ypb) + wave * 64 + lane;
    f32x4 kkq[3], wq[3], bq[3], kq[3], rq[3]; f32x4 vq4[2];
#pragma unroll
    for (int u = 0; u < 2; ++u) { kkq[u] = base[u * 16]; wq[u] = base[L_WW / 16 + u * 16]; bq[u] = base[L_BB / 16 + u * 16]; kq[u] = base[L_KP / 16 + u * 16]; rq[u] = base[L_RR / 16 + u * 16]; }
    vq4[0] = vb4[0];
#pragma unroll
    for (int t = 0; t < SC; ++t) {
        const int tn = (t + 2 < SC) ? t + 2 : SC - 1; const int sl = (t + 2) % 3, cu = t % 3;
        kkq[sl] = base[tn * 16]; wq[sl] = base[L_WW / 16 + tn * 16]; bq[sl] = base[L_BB / 16 + tn * 16]; kq[sl] = base[L_KP / 16 + tn * 16]; rq[sl] = base[L_RR / 16 + tn * 16];
        if ((t & 3) == 0 && t + 4 < SC) vq4[((t >> 2) + 1) & 1] = vb4[(t >> 2) + 1];
        const f32x4 kk4 = kkq[cu], w4 = wq[cu], b4 = bq[cu], k4 = kq[cu], r4 = rq[cu]; const float vv = vq4[(t >> 2) & 1][t & 3];
        float sa = fmaf(S.w, kk4.w, fmaf(S.z, kk4.z, fmaf(S.y, kk4.y, S.x * kk4.x)));
        const f32x4 vk = vv * k4;
        sa = -red16(sa);
        S = S * w4 + (sa * b4 + vk);
        yp[t * 256] = fmaf(S.w, r4.w, fmaf(S.z, r4.z, fmaf(S.y, r4.y, S.x * r4.x)));
    }
}
#define SCAN_BAR() do { asm volatile("s_waitcnt lgkmcnt(0)" ::: "memory"); __builtin_amdgcn_s_barrier(); asm volatile("" ::: "memory"); } while (0)
__device__ __forceinline__ void phase_scan(KP p, unsigned char* ldsg, int tid, int lane, int wave) {
    unsigned char* ws = p->wsb;
    const bf16_t* PS = (const bf16_t*)(ws + OFF_PS); const _Float16* LO = (const _Float16*)(ws + OFF_LO); float* YR = (float*)(ws + OFF_YRAW);
    LAS unsigned char* lds = (LAS unsigned char*)ldsg;
    const int G = gridDim.x, bx = blockIdx.x; const int vcu = (G % 8 == 0) ? (bx % 8) * (G / 8) + bx / 8 : bx;
    constexpr int NCH = T_SEQ / SC;
    int iter = 0;
    for (int su = vcu; su < 256; su += G, ++iter) {
        const int hp = su >> 2, q = su & 3, b = hp >> 5, h = hp & 31;
        const size_t tokb = (size_t)b * T_SEQ; const int colbase = h * 64 + q * 16;
#ifdef PROBE_ISO
        { f32x4 Sp = {0.f, 0.f, 0.f, 0.f};
          if (wave < 4) { for (int c = 0; c < PROBE_ISO; ++c) { scan_consume(Sp, lds, lds + L_YP, lane & 15, wave * 4 + (lane >> 4), wave, lane); asm volatile("" ::: "memory"); }
              if (Sp.x == 1.2345e-30f) YR[0] = Sp.y; }
          __syncthreads(); }
#endif
        if (wave >= 4) {
            const int tid2 = tid - 256, pt = tid2 >> 3, kb = (tid2 & 7) * 8, hc = h * 64 + kb;
            ScanConst C;
#pragma unroll
            for (int e = 0; e < 8; ++e) { C.mur[e] = p->mu[hc + e]; C.muk[e] = p->mu[2048 + hc + e]; C.muv[e] = p->mu[4096 + hc + e]; C.kk_[e] = p->k_k[hc + e]; C.ka[e] = p->k_a[hc + e]; C.rk[e] = p->r_k[hc + e]; }
            ScanRaw A, B;
            ScanOff so; so.r = (unsigned)(pt * PSW + hc) * 2u; so.k = so.r + 4096u; so.v = so.r + 8192u; so.e = (unsigned)(pt * LN_ + hc) * 2u; so.a = so.e + 4096u;
            const bufrsrc_t rsP = make_rsrc(PS), rsL = make_rsrc(LO);
            const unsigned pbase = (unsigned)(tokb * PSW * 2), lbase = (unsigned)(tokb * LN_ * 2);
            scan_load(A, PS, LO, tokb + pt, pt > 0, hc);
            float* const BON = (float*)(ws + OFF_BON); const bool bw = (q == 0) && (kb == 0);
            scan_prep(lds, C, A, pt, kb, q, bw ? BON + (tokb + pt) * 32 + h : nullptr);
            scan_load(A, PS, LO, tokb + SC + pt, true, hc);
            const int w4 = wave - 4; BgRegs BG; int bg_cur = -1;
            int bg_next = (iter * NCH) * G + bx;
            SCAN_BAR();
            for (int c = 0; c < NCH; ++c) {
                if (c + 1 < NCH) { B = A;
                    if (c + 2 < NCH) scan_load_buf(A, rsP, rsL, so, pbase + (unsigned)(c + 2) * (unsigned)(SC * PSW * 2), lbase + (unsigned)(c + 2) * (unsigned)(SC * LN_ * 2));
                    scan_prep(lds + ((c + 1) & 1) * SBUF, C, B, pt, kb, q, bw ? BON + (tokb + (size_t)(c + 1) * SC + pt) * 32 + h : nullptr); }
                if (c >= 1) scan_yreduce(lds + L_YP + ((c - 1) & 1) * YPB, YR, tokb + (size_t)(c - 1) * SC, colbase, tid2);
                if (bg_cur >= 0) { bg_store(p, BG, bg_cur, w4, lane); bg_cur = -1; }
                if (bg_next < BG_ITEMS) { bg_load(p, BG, bg_next, w4, lane); bg_cur = bg_next; }
                bg_next += G;
                SCAN_BAR();
            }
            if (bg_cur >= 0) bg_store(p, BG, bg_cur, w4, lane);
            scan_yreduce(lds + L_YP + ((NCH - 1) & 1) * YPB, YR, tokb + (size_t)(NCH - 1) * SC, colbase, tid2);
        } else {
            const int j = lane & 15, rl = wave * 4 + (lane >> 4);
            f32x4 S = {0.f, 0.f, 0.f, 0.f};
            __builtin_amdgcn_s_setprio(3);
            SCAN_BAR();
            for (int c = 0; c < NCH; ++c) {
                scan_consume(S, lds + (c & 1) * SBUF, lds + L_YP + (c & 1) * YPB, j, rl, wave, lane);
                SCAN_BAR();
            }
            __builtin_amdgcn_s_setprio(0);
        }
        __syncthreads();
    }
    if (wave >= 4) { BgRegs BG; for (int item = (iter * NCH) * G + bx; item < BG_ITEMS; item += G) { bg_load(p, BG, item, wave - 4, lane); bg_store(p, BG, item, wave - 4, lane); } }
}

__device__ __forceinline__ void phase_post(KP p, int gw, int NGW, int lane) {
    unsigned char* ws = p->wsb;
    const bf16_t* PS = (const bf16_t*)(ws + OFF_PS); const _Float16* LO = (const _Float16*)(ws + OFF_LO); const float* YR = (const float*)(ws + OFF_YRAW); const float* BON = (const float*)(ws + OFF_BON); bf16_t* Y = (bf16_t*)(ws + OFF_Y);
    for (int tok = gw; tok < M_TOK; tok += NGW) {
        const bool hasp = (tok % T_SEQ) != 0;
        const bf16_t* row = PS + (size_t)tok * PSW; const bf16_t* prow = row - PSW;
#pragma unroll 2
        for (int hg = 0; hg < 8; ++hg) { const int col = hg * 256 + lane * 4;
            const f32x4 y = *(const f32x4*)(YR + (size_t)tok * RW + col);
            const u32x2 z2 = {0u, 0u};
            const u32x2 vc = *(const u32x2*)(row + 4096 + col);
            const u32x2 vp = hasp ? *(const u32x2*)(prow + 4096 + col) : z2;
            const f32x4 muv = *(const f32x4*)(p->mu + 4096 + col);
            typedef _Float16 h4 __attribute__((ext_vector_type(4))); const h4 g2 = *(const h4*)(LO + (size_t)tok * LN_ + 4096 + col);
            const f32x4 lg = *(const f32x4*)(p->lnx_g + col), lb = *(const f32x4*)(p->lnx_b + col);
            const float bonus = BON[(size_t)tok * 32 + hg * 4 + (lane >> 4)];
            const f32x4 vcf = {bflo(vc.x), bfhi(vc.x), bflo(vc.y), bfhi(vc.y)}, vpf = {bflo(vp.x), bfhi(vp.x), bflo(vp.y), bfhi(vp.y)};
            const f32x4 gf = {(float)g2[0], (float)g2[1], (float)g2[2], (float)g2[3]};
            const f32x4 v = vcf + (vpf - vcf) * muv;
            const float mean = red16((y.x + y.y) + (y.z + y.w)) * (1.0f / 64.0f);
            const f32x4 d = y - mean;
            const float var = red16((d.x * d.x + d.y * d.y) + (d.z * d.z + d.w * d.w)) * (1.0f / 64.0f);
            const float rstd = rsqrtf(var + 64e-5f);
            const f32x4 o = ((d * rstd) * lg + lb + bonus * v) * gf;
            u32x2 w; w.x = pk2(o.x, o.y); w.y = pk2(o.z, o.w);
            *(u32x2*)(Y + (size_t)tok * DM + 2048 + col) = w; }
    }
}

__device__ __forceinline__ void phase7(KP p, int gw, int NGW, int lane) {
    unsigned char* ws = p->wsb;
    const bf16_t* MIX = (const bf16_t*)(ws + OFF_MIX); const float* SS = (const float*)(ws + OFF_SS1); bf16_t* H = (bf16_t*)(ws + OFF_H);
    for (int row = gw; row < M_TOK; row += NGW) {
        const float* gp1 = p->post_mix_g; const float* gp2 = p->pre_ffn_g; asm volatile("" : "+s"(gp1), "+s"(gp2));
        const float rs1 = rsqrtf(wave_sum(SS[(size_t)row * 64 + lane]) * (1.0f / DM) + 1e-6f);
        const f32x4* xr = (const f32x4*)(p->x + (size_t)row * DM) + lane; const u32x2* mr = (const u32x2*)(MIX + (size_t)row * DM) + lane;
        u32x2* x1row = (u32x2*)(p->out + (size_t)row * DM) + lane; u32x2* hrow = (u32x2*)(H + (size_t)row * DM) + lane;
        f32x4 v[16]; float s = 0.f;
#pragma unroll
        for (int jh = 0; jh < 4; ++jh) {
            const f32x4* xg = xr + 256 * jh; const u32x2* mg = mr + 256 * jh; const f32x4* gg1 = (const f32x4*)gp1 + lane + 256 * jh; asm volatile("" : "+v"(xg), "+v"(mg), "+v"(gg1));
#pragma unroll
            for (int jj = 0; jj < 4; ++jj) { const int j = jh * 4 + jj; const f32x4 xx = xg[64 * jj]; const u32x2 mm = mg[64 * jj]; const f32x4 g = gg1[64 * jj];
                const f32x4 mf = {bflo(mm.x), bfhi(mm.x), bflo(mm.y), bfhi(mm.y)};
                v[j] = xx + (mf * rs1) * g; s += (v[j].x * v[j].x + v[j].y * v[j].y) + (v[j].z * v[j].z + v[j].w * v[j].w); }
            asm volatile("" ::: "memory"); }
        const float rs2 = rsqrtf(wave_sum(s) * (1.0f / DM) + 1e-6f);
#pragma unroll
        for (int jh = 0; jh < 4; ++jh) {
            u32x2* x1g = x1row + 256 * jh; u32x2* hg = hrow + 256 * jh; const f32x4* gg2 = (const f32x4*)gp2 + lane + 256 * jh; asm volatile("" : "+v"(x1g), "+v"(hg), "+v"(gg2));
#pragma unroll
            for (int jj = 0; jj < 4; ++jj) { const int j = jh * 4 + jj; const f32x4 g = gg2[64 * jj];
                u32x2 w; w.x = pk2(v[j].x, v[j].y); w.y = pk2(v[j].z, v[j].w); x1g[64 * jj] = w;
                u32x2 h; h.x = pk2(v[j].x * rs2 * g.x, v[j].y * rs2 * g.y); h.y = pk2(v[j].z * rs2 * g.z, v[j].w * rs2 * g.w); hg[64 * jj] = h; }
            asm volatile("" ::: "memory"); }
    }
}
__device__ __forceinline__ void phase10(KP p, int gw, int NGW, int lane) {
    unsigned char* ws = p->wsb;
    const bf16_t* F = (const bf16_t*)(ws + OFF_F); const float* SS = (const float*)(ws + OFF_SS2);
    for (int row = gw; row < M_TOK; row += NGW) {
        const float* gp3 = p->post_ffn_g; asm volatile("" : "+s"(gp3));
        const float rs = rsqrtf(wave_sum(SS[(size_t)row * 64 + lane]) * (1.0f / DM) + 1e-6f);
        f32x4* orow = (f32x4*)(p->out + (size_t)row * DM) + lane; const u32x2* x1row = (const u32x2*)(p->out + (size_t)row * DM) + lane; const u32x2* fr_ = (const u32x2*)(F + (size_t)row * DM) + lane;
        u32x2 xb[16], fb[16];
#pragma unroll
        for (int j = 0; j < 16; ++j) { xb[j] = x1row[64 * j]; fb[j] = fr_[64 * j]; }
        asm volatile("s_waitcnt vmcnt(0)" ::: "memory");
#pragma unroll
        for (int j = 0; j < 16; ++j) { const f32x4 g = ((const f32x4*)gp3)[lane + 64 * j];
            const f32x4 xx = {bflo(xb[j].x), bfhi(xb[j].x), bflo(xb[j].y), bfhi(xb[j].y)}, mf = {bflo(fb[j].x), bfhi(fb[j].x), bflo(fb[j].y), bfhi(fb[j].y)};
            orow[64 * j] = xx + (mf * rs) * g; }
    }
}

constexpr int NPHASE = 11;
__global__ void __launch_bounds__(NTHREADS, 2) fwd_megakernel(Params p_) {
    extern __shared__ __attribute__((aligned(16))) unsigned char lds[];
    const int tid = threadIdx.x, lane = tid & 63, wave = __builtin_amdgcn_readfirstlane(tid >> 6);
    const int G = gridDim.x, gw = blockIdx.x * NWAVES + wave, NGW = G * NWAVES;
    const int lo = p_.ph_lo, hi = p_.ph_hi;
    volatile LAS unsigned* xst = (volatile LAS unsigned*)((LAS unsigned char*)lds + (LDS_BYTES - 16));
    XcdBarrier xbar; xbar.bar = nullptr; xbar.x = 0; xbar.st = xst;
    if (p_.coop) { if (tid == 0) { xst[0] = 0u; xst[1] = 0u; } __syncthreads(); xbar = xcd_barrier_post((unsigned*)(p_.wsb + OFF_BAR), xst); }
    if (p_.coop == 2) cg::this_grid().sync();
#define GRIDBAR() xcd_barrier(xbar)
#ifndef PH_MASK
#define PH_MASK 0x7ff
#endif
#define IN(k) ((((PH_MASK) >> (k)) & 1) && lo <= (k) && (k) < hi)
#define SEAM(k) do { if (IN(k) && IN((k) + 1)) { GRIDBAR(); } } while (0)
#ifndef REPEAT_MASK
#define REPEAT_MASK 0
#endif
#define REPS(k) ((((REPEAT_MASK) >> (k)) & 1) ? 2 : 1)
#define RSYNC(k, r) do { if ((r) + 1 < REPS(k)) GRIDBAR(); } while (0)
    if (IN(0)) { for (int rep = 0; rep < REPS(0); ++rep) { KP p = kparams(); phase0(p, lds, gw, NGW, lane, wave); RSYNC(0, rep); } } SEAM(0);
    if (IN(1)) for (int rep = 0; rep < REPS(1); ++rep) { KP p = kparams(); unsigned char* ws = p->wsb; pg8::Gemm g{(const bf16_t*)(ws + OFF_H), (const bf16_t*)(ws + OFF_WIN), M_TOK, NPAD, DM, DM}; pg8::StaticOrder S; S.init(M_TOK, NPAD, G, (int)blockIdx.x);
        EpiProj E{(bf16_t*)(ws + OFF_Z), (bf16_t*)(ws + OFF_PS)};
        pg8::gemm_phase<EpiProj, pg8::StaticOrder>((PG8_LAS unsigned char*)lds, g, S, E, nullptr); RSYNC(1, rep); } SEAM(1);
    if (IN(2)) { for (int rep = 0; rep < REPS(2); ++rep) { KP p = kparams(); phase2(p, gw, NGW, lane); RSYNC(2, rep); } } SEAM(2);
    if (IN(3)) for (int rep = 0; rep < REPS(3); ++rep) { KP p = kparams(); unsigned char* ws = p->wsb; { pg8::Gemm g{(const bf16_t*)(ws + OFF_A2), (const bf16_t*)(ws + OFF_BT2), M_TOK, 4096, 256, LK}; pg8::StaticOrder S; S.init(M_TOK, 4096, G, (int)blockIdx.x, 0);
          EpiF16 E{(unsigned short*)(ws + OFF_LO), p->w0, p->a0, 0};
          pg8::gemm_phase<EpiF16, pg8::StaticOrder>((PG8_LAS unsigned char*)lds, g, S, E, nullptr); }
        { pg8::Gemm g{(const bf16_t*)(ws + OFF_A2), (const bf16_t*)(ws + OFF_BT2) + (size_t)4096 * LK, M_TOK, 2048, 256, LK}; pg8::StaticOrder S; S.init(M_TOK, 2048, G, (int)blockIdx.x, 128);
          EpiF16 E{(unsigned short*)(ws + OFF_LO), p->w0, p->a0, 16};
          pg8::gemm_phase<EpiF16, pg8::StaticOrder>((PG8_LAS unsigned char*)lds, g, S, E, nullptr); }
        __syncthreads();
        phase_gmlp(p, lds, tid, lane, wave); RSYNC(3, rep); } SEAM(3);
    if (IN(4)) { for (int rep = 0; rep < REPS(4); ++rep) { KP p = kparams(); phase_scan(p, lds, tid, lane, wave); RSYNC(4, rep); } } SEAM(4);
    if (IN(5)) { for (int rep = 0; rep < REPS(5); ++rep) { KP p = kparams(); phase_post(p, gw, NGW, lane); RSYNC(5, rep); } } SEAM(5);
    if (IN(6)) for (int rep = 0; rep < REPS(6); ++rep) { KP p = kparams(); unsigned char* ws = p->wsb; pg8::Gemm g{(const bf16_t*)(ws + OFF_Y), (const bf16_t*)(ws + OFF_WOT), M_TOK, DM, DM, DM}; pg8::StaticOrder S; S.init(M_TOK, DM, G, (int)blockIdx.x);
        EpiNormPart E{(bf16_t*)(ws + OFF_MIX), (float*)(ws + OFF_SS1)};
        pg8::gemm_phase<EpiNormPart, pg8::StaticOrder>((PG8_LAS unsigned char*)lds, g, S, E, nullptr); RSYNC(6, rep); } SEAM(6);
    if (IN(7)) { for (int rep = 0; rep < REPS(7); ++rep) { KP p = kparams(); phase7(p, gw, NGW, lane); RSYNC(7, rep); } } SEAM(7);
    if (IN(8)) for (int rep = 0; rep < REPS(8); ++rep) { KP p = kparams(); unsigned char* ws = p->wsb; pg8::Gemm g{(const bf16_t*)(ws + OFF_H), (const bf16_t*)(ws + OFF_W1T), M_TOK, FFD, DM, DM}; pg8::StaticOrder S; S.init(M_TOK, FFD, G, (int)blockIdx.x);
        EpiRelu2 E{(bf16_t*)(ws + OFF_HID)};
        pg8::gemm_phase<EpiRelu2, pg8::StaticOrder>((PG8_LAS unsigned char*)lds, g, S, E, nullptr); RSYNC(8, rep); } SEAM(8);
    if (IN(9)) for (int rep = 0; rep < REPS(9); ++rep) { KP p = kparams(); unsigned char* ws = p->wsb; pg8::Gemm g{(const bf16_t*)(ws + OFF_HID), (const bf16_t*)(ws + OFF_W2T), M_TOK, DM, FFD, FFD}; pg8::StaticOrder S; S.init(M_TOK, DM, G, (int)blockIdx.x);
        EpiNormPart E{(bf16_t*)(ws + OFF_F), (float*)(ws + OFF_SS2)};
        pg8::gemm_phase<EpiNormPart, pg8::StaticOrder>((PG8_LAS unsigned char*)lds, g, S, E, nullptr); RSYNC(9, rep); } SEAM(9);
    if (IN(10)) { KP p = kparams(); phase10(p, gw, NGW, lane); }
#undef IN
#undef SEAM
}

#ifndef N_LAUNCH_MODE
#define N_LAUNCH_MODE 1
#endif
extern "C" void kernel_launch(void* const* d_in, const int* in_sizes, int n_in, void* d_out, int out_size, void* d_ws, size_t ws_size, hipStream_t stream) {
    static int grid = 0;
    if (grid == 0) {
        int dev = 0, cus = 0, per_cu = 0;
        (void)hipGetDevice(&dev); (void)hipDeviceGetAttribute(&cus, hipDeviceAttributeMultiprocessorCount, dev);
        if (hipFuncSetAttribute((const void*)fwd_megakernel, hipFuncAttributeMaxDynamicSharedMemorySize, LDS_BYTES) != hipSuccess) fprintf(stderr, "hipFuncSetAttribute failed\n");
        if (hipOccupancyMaxActiveBlocksPerMultiprocessor(&per_cu, (const void*)fwd_megakernel, NTHREADS, LDS_BYTES) != hipSuccess || per_cu < 1) { fprintf(stderr, "occupancy query: %d\n", per_cu); per_cu = 1; }
        (void)hipGetLastError();
        grid = cus * 1;
        if (n_in != 24 || ws_size < WS_END) fprintf(stderr, "unexpected n_in %d / ws_size %zu (need %zu)\n", n_in, ws_size, (size_t)WS_END);
    }
    Params p{};
    const float** pp = (const float**)&p;
    for (int i = 0; i < 24; ++i) pp[i] = (const float*)d_in[i];
    p.out = (float*)d_out; p.wsb = (unsigned char*)d_ws; p.pad = 0;
#if N_LAUNCH_MODE == 1
    p.ph_lo = 0; p.ph_hi = NPHASE; p.coop = 1;
    (void)hipMemsetAsync((unsigned char*)d_ws + OFF_BAR, 0, 16384, stream);
    void* args[] = {&p};
    hipError_t e = hipLaunchCooperativeKernel((const void*)fwd_megakernel, dim3(grid), dim3(NTHREADS), args, LDS_BYTES, stream);
    if (e != hipSuccess) fprintf(stderr, "cooperative launch failed: %s (grid %d)\n", hipGetErrorString(e), grid);
#else
    for (int ph = 0; ph < NPHASE; ++ph) { p.ph_lo = ph; p.ph_hi = ph + 1; p.coop = 0;
        hipLaunchKernelGGL(fwd_megakernel, dim3(grid), dim3(NTHREADS), LDS_BYTES, stream, p); }
#endif
}
```
